# Optimizing an MI355X kernel written in HIP

```python
import jax, jax.numpy as jnp
from jax import lax
import numpy as np

D_MODEL = 2048
BATCH = 2
SEQ = 4096
DEPTH = 1

HEAD_DIM = 128
EPS = 1e-6
A_PATTERNS = ((128, 1), (512, 4), (2048, 16))
A_N_GROUPS = len(A_PATTERNS)
A_HEADS = 4
A_WIDTH = A_HEADS * HEAD_DIM
ROPE_THETA = 500000.0
ROPE_DIMS = HEAD_DIM // 4
B_Q_HEADS = 16
B_KV_HEADS = 4
B_GROUP = B_Q_HEADS // B_KV_HEADS
B_Q_WIDTH = B_Q_HEADS * HEAD_DIM
B_KV_WIDTH = B_KV_HEADS * HEAD_DIM
AXIAL_THETA = 10000.0
AXIAL_DIMS = HEAD_DIM // 2
GRID_W = 64
Q_BLOCK = 128
A_COLS = A_N_GROUPS * 3 * A_WIDTH
B_COLS = B_Q_WIDTH + 2 * B_KV_WIDTH
GATE_COLS = 2 * D_MODEL
IN_COLS = A_COLS + B_COLS + GATE_COLS
N_MOD = 6
N_EXPERTS = 64
N_EXPERT_GROUPS = 8
TOPK_GROUPS = 4
TOP_K = 8
D_EXPERT = D_MODEL // 4
D_SHARED = D_MODEL // 4
ROUTED_SCALE = 2.5
MOE_BLOCK = 128
NEG = -1e30

kernel_name = 'hybrid_dilated_gqa_moe_block'


def rmsnorm(x, g):
    xf = x.astype(jnp.float32)
    y = xf * lax.rsqrt(jnp.mean(xf * xf, axis=-1, keepdims=True) + EPS)
    return (y * g.astype(jnp.float32)).astype(x.dtype)


def rotate(x, cos, sin):
    half = x.shape[-1] // 2
    x1, x2 = x[..., :half], x[..., half:]
    return jnp.concatenate([x1 * cos - x2 * sin, x2 * cos + x1 * sin], axis=-1)


def rope_angles(pos, dims, theta):
    inv = jnp.power(jnp.float32(theta), -jnp.arange(0, dims, 2, dtype=jnp.float32) / dims)
    return pos.astype(jnp.float32)[:, None] * inv[None, :]


def partial_rope(x):
    s = x.shape[2]
    ang = rope_angles(jnp.arange(s), ROPE_DIMS, ROPE_THETA)
    cos, sin = jnp.cos(ang).astype(x.dtype), jnp.sin(ang).astype(x.dtype)
    return jnp.concatenate([rotate(x[..., :ROPE_DIMS], cos, sin), x[..., ROPE_DIMS:]], axis=-1)


def axial_rope(x):
    s = x.shape[1]
    rows = s // GRID_W
    row_id = jnp.broadcast_to(jnp.arange(rows)[:, None], (rows, GRID_W)).reshape(-1)
    col_id = jnp.broadcast_to(jnp.arange(GRID_W)[None, :], (rows, GRID_W)).reshape(-1)
    ang_r = rope_angles(row_id, AXIAL_DIMS, AXIAL_THETA)[:, None, :]
    ang_c = rope_angles(col_id, AXIAL_DIMS, AXIAL_THETA)[:, None, :]
    xr = rotate(x[..., :AXIAL_DIMS], jnp.cos(ang_r).astype(x.dtype), jnp.sin(ang_r).astype(x.dtype))
    xc = rotate(x[..., AXIAL_DIMS:], jnp.cos(ang_c).astype(x.dtype), jnp.sin(ang_c).astype(x.dtype))
    return jnp.concatenate([xr, xc], axis=-1)


def banded_attention(q, k, v, half_window):
    b, h, L, hd = q.shape
    P = half_window
    nb = -(-L // P)
    Lp = nb * P
    qb = jnp.pad(q, ((0, 0), (0, 0), (0, Lp - L), (0, 0))).reshape(b, h, nb, P, hd)
    kv_pad = ((0, 0), (0, 0), (P, Lp - L + P), (0, 0))
    kb = jnp.pad(k, kv_pad).reshape(b, h, nb + 2, P, hd)
    vb = jnp.pad(v, kv_pad).reshape(b, h, nb + 2, P, hd)
    kwin = jnp.concatenate([kb[:, :, :-2], kb[:, :, 1:-1], kb[:, :, 2:]], axis=3)
    vwin = jnp.concatenate([vb[:, :, :-2], vb[:, :, 1:-1], vb[:, :, 2:]], axis=3)
    q_pos = jnp.arange(Lp).reshape(nb, P)
    k_pos = jnp.arange(nb)[:, None] * P - P + jnp.arange(3 * P)[None, :]
    kp = k_pos[:, None, :]
    valid = (jnp.abs(q_pos[:, :, None] - kp) <= half_window) & (kp >= 0) & (kp < L)
    sc = jnp.einsum('bhnqd,bhnkd->bhnqk', qb, kwin).astype(jnp.float32) * (hd ** -0.5)
    sc = jnp.where(valid, sc, NEG)
    lse = jax.nn.logsumexp(sc, axis=-1)
    p = jnp.exp(sc - lse[..., None])
    o = jnp.einsum('bhnqk,bhnkd->bhnqd', p.astype(v.dtype), vwin)
    return o.reshape(b, h, Lp, hd)[:, :, :L], lse.reshape(b, h, Lp)[:, :, :L]


def dilated_attention(q, k, v, window, dilation):
    b, h, s, hd = q.shape
    L = s // dilation

    def split(z):
        return z.reshape(b, h, L, dilation, hd).transpose(0, 1, 3, 2, 4).reshape(b, h * dilation, L, hd)

    o, lse = banded_attention(split(q), split(k), split(v), (window // 2) // dilation)
    o = o.reshape(b, h, dilation, L, hd).transpose(0, 1, 3, 2, 4).reshape(b, h, s, hd)
    lse = lse.reshape(b, h, dilation, L).transpose(0, 1, 3, 2).reshape(b, h, s)
    return o, lse


def mixer_a(a_cols):
    b, s, _ = a_cols.shape
    a = a_cols.reshape(b, s, A_N_GROUPS, 3, A_HEADS, HEAD_DIM).transpose(2, 3, 0, 4, 1, 5)
    outs, lses = [], []
    for gi, (window, dilation) in enumerate(A_PATTERNS):
        q = partial_rope(a[gi, 0])
        k = partial_rope(a[gi, 1])
        o, lse = dilated_attention(q, k, a[gi, 2], window, dilation)
        outs.append(o)
        lses.append(lse)
    w = jax.nn.softmax(jnp.stack(lses, axis=0), axis=0)
    o = jnp.sum(w[..., None].astype(outs[0].dtype) * jnp.stack(outs, axis=0), axis=0)
    return o.transpose(0, 2, 1, 3).reshape(b, s, A_WIDTH)


def mixer_b(qc, kc, vc, q_norm_g, k_norm_g):
    b, s, _ = qc.shape
    q = axial_rope(rmsnorm(qc.reshape(b, s, B_Q_HEADS, HEAD_DIM), q_norm_g))
    k = axial_rope(rmsnorm(kc.reshape(b, s, B_KV_HEADS, HEAD_DIM), k_norm_g))
    v = vc.reshape(b, s, B_KV_HEADS, HEAD_DIM).transpose(0, 2, 1, 3)
    k = k.transpose(0, 2, 1, 3)
    q = q.reshape(b, s, B_KV_HEADS, B_GROUP, HEAD_DIM).transpose(0, 2, 3, 1, 4)
    nblk = s // Q_BLOCK
    qb = q.reshape(b, B_KV_HEADS, B_GROUP, nblk, Q_BLOCK, HEAD_DIM).transpose(3, 0, 1, 2, 4, 5)
    scale = HEAD_DIM ** -0.5

    def one_block(qblk):
        sc = jnp.einsum('bkgqd,bksd->bkgqs', qblk, k).astype(jnp.float32) * scale
        p = jax.nn.softmax(sc, axis=-1)
        return jnp.einsum('bkgqs,bksd->bkgqd', p.astype(v.dtype), v)

    o = lax.map(one_block, qb)
    return o.transpose(1, 0, 4, 2, 3, 5).reshape(b, s, B_Q_WIDTH)


def moe(h, w_router, e_bias, w1, w3, w2, ws1, ws3, ws2):
    b, s, d = h.shape
    t = h.reshape(b * s, d)
    n_tok = t.shape[0]
    scores = jax.nn.sigmoid((t @ w_router).astype(jnp.float32))
    sel = scores + e_bias.astype(jnp.float32)
    per_group = N_EXPERTS // N_EXPERT_GROUPS
    grp_score = jnp.sum(lax.top_k(sel.reshape(n_tok, N_EXPERT_GROUPS, per_group), 2)[0], axis=-1)
    _, top_g = lax.top_k(grp_score, TOPK_GROUPS)
    gmask = jnp.any(top_g[:, :, None] == jnp.arange(N_EXPERT_GROUPS)[None, None, :], axis=1)
    emask = jnp.repeat(gmask, per_group, axis=1)
    _, top_e = lax.top_k(jnp.where(emask, sel, -jnp.inf), TOP_K)
    chosen = jnp.take_along_axis(scores, top_e, axis=1)
    wts = chosen / jnp.sum(chosen, axis=-1, keepdims=True) * ROUTED_SCALE
    gate = jnp.sum(jax.nn.one_hot(top_e, N_EXPERTS, dtype=jnp.float32) * wts[..., None], axis=1)
    gate = gate.astype(t.dtype)
    nb = n_tok // MOE_BLOCK

    def expert_block(args):
        tb, gb = args
        a = jnp.einsum('td,edf->tef', tb, w1)
        u = jnp.einsum('td,edf->tef', tb, w3)
        hid = jax.nn.silu(a) * u * gb[..., None]
        return jnp.einsum('tef,efd->td', hid, w2)

    routed = lax.map(expert_block, (t.reshape(nb, MOE_BLOCK, d), gate.reshape(nb, MOE_BLOCK, N_EXPERTS)))
    shared = (jax.nn.silu(t @ ws1) * (t @ ws3)) @ ws2
    return (routed.reshape(n_tok, d) + shared).reshape(b, s, d)


def setup_inputs(seed: int = 0) -> dict:
    key = jax.random.key(seed)
    ks = jax.random.split(key, 24)
    f32 = jnp.float32

    def nrm(k, shape, fan_in, mult=1.0):
        return jax.random.normal(k, shape, f32) * (mult * fan_in ** -0.5)

    L = DEPTH
    return {
        'x': jax.random.normal(ks[0], (BATCH, SEQ, D_MODEL), f32),
        'c': jax.random.normal(ks[1], (BATCH, D_MODEL), f32),
        'w_ada': nrm(ks[2], (L, D_MODEL, N_MOD * D_MODEL), D_MODEL, 0.5),
        'b_ada': 0.02 * jax.random.normal(ks[3], (L, N_MOD * D_MODEL), f32),
        'g_attn': 1.0 + 0.05 * jax.random.normal(ks[4], (L, D_MODEL), f32),
        'w_in': nrm(ks[5], (L, D_MODEL, IN_COLS), D_MODEL),
        'b_gate': 0.02 * jax.random.normal(ks[6], (L, GATE_COLS), f32),
        'q_norm_g': 1.0 + 0.05 * jax.random.normal(ks[7], (L, HEAD_DIM), f32),
        'k_norm_g': 1.0 + 0.05 * jax.random.normal(ks[8], (L, HEAD_DIM), f32),
        'w_a_up': nrm(ks[9], (L, A_WIDTH, D_MODEL), A_WIDTH),
        'w_b_up': nrm(ks[10], (L, B_Q_WIDTH, D_MODEL), B_Q_WIDTH),
        'w_out': nrm(ks[11], (L, D_MODEL, D_MODEL), D_MODEL),
        'g_ffn': 1.0 + 0.05 * jax.random.normal(ks[12], (L, D_MODEL), f32),
        'w_router': nrm(ks[13], (L, D_MODEL, N_EXPERTS), D_MODEL),
        'e_bias': 0.01 * jax.random.normal(ks[14], (L, N_EXPERTS), f32),
        'w1': nrm(ks[15], (L, N_EXPERTS, D_MODEL, D_EXPERT), D_MODEL),
        'w3': nrm(ks[16], (L, N_EXPERTS, D_MODEL, D_EXPERT), D_MODEL),
        'w2': nrm(ks[17], (L, N_EXPERTS, D_EXPERT, D_MODEL), D_EXPERT),
        'ws1': nrm(ks[18], (L, D_MODEL, D_SHARED), D_MODEL),
        'ws3': nrm(ks[19], (L, D_MODEL, D_SHARED), D_MODEL),
        'ws2': nrm(ks[20], (L, D_SHARED, D_MODEL), D_SHARED),
        'g_final': 1.0 + 0.05 * jax.random.normal(ks[21], (D_MODEL,), f32),
    }


def reference(x, c, w_ada, b_ada, g_attn, w_in, b_gate, q_norm_g, k_norm_g, w_a_up, w_b_up, w_out,
              g_ffn, w_router, e_bias, w1, w3, w2, ws1, ws3, ws2, g_final):
    c_act = jax.nn.silu(c)
    for l in range(DEPTH):
        mod = c_act @ w_ada[l] + b_ada[l]
        sh1, sc1, gt1, sh2, sc2, gt2 = jnp.split(mod[:, None, :], N_MOD, axis=-1)
        h = rmsnorm(x, g_attn[l]) * (1.0 + sc1) + sh1
        proj = h @ w_in[l]
        o1 = A_COLS
        o2 = o1 + B_Q_WIDTH
        o3 = o2 + B_KV_WIDTH
        o4 = o3 + B_KV_WIDTH
        y_a = mixer_a(proj[..., :o1]) @ w_a_up[l]
        y_b = mixer_b(proj[..., o1:o2], proj[..., o2:o3], proj[..., o3:o4], q_norm_g[l], k_norm_g[l]) @ w_b_up[l]
        gates = jax.nn.sigmoid(proj[..., o4:] + b_gate[l])
        merged = gates[..., :D_MODEL] * y_a + gates[..., D_MODEL:] * y_b
        x = x + gt1 * (merged @ w_out[l])
        h2 = rmsnorm(x, g_ffn[l]) * (1.0 + sc2) + sh2
        x = x + gt2 * moe(h2, w_router[l], e_bias[l], w1[l], w3[l], w2[l], ws1[l], ws3[l], ws2[l])
    return rmsnorm(x, g_final)
```

```cpp
#include <hip/hip_runtime.h>
#include <cstdio>
#include <cstdint>

#ifndef MK_N_LAUNCHES
#define MK_N_LAUNCHES 1
#endif

#ifndef PROBE_REP
#define FORCE_NF 3
#define PROBE_REP 0
#endif
#define LAS __attribute__((address_space(3)))
#define GAS __attribute__((address_space(1)))
typedef unsigned short bf16_t;
typedef short bf16x8 __attribute__((ext_vector_type(8)));
typedef short s16x4 __attribute__((ext_vector_type(4)));
typedef float f32x2 __attribute__((ext_vector_type(2)));
typedef float f32x4 __attribute__((ext_vector_type(4)));
typedef float f32x16 __attribute__((ext_vector_type(16)));
typedef unsigned u32x2 __attribute__((ext_vector_type(2)));
typedef unsigned u32x4 __attribute__((ext_vector_type(4)));

constexpr int DM = 2048, NBATCH = 2, SEQ = 4096, MTOK = NBATCH * SEQ, HD = 128;
constexpr int A_COLS = 4608, BQ_OFF = 4608, BK_OFF = 6656, BV_OFF = 7168, GATE_OFF = 7680, IN_COLS = 11776;
constexpr int KAB = 512 + DM;
constexpr int NE = 64, NEX = 65, DE = 512, ECAP = 8192;
constexpr float EPS = 1e-6f;
constexpr float WG_SCALE = 64.0f, WG_DESCALE = 1.0f / 64.0f;
constexpr float W13_SCALE = 64.0f, W13_DESCALE = 1.0f / 64.0f;
constexpr float WO_SCALE = 64.f, MG_SCALE = 64.f, X1_DESCALE = 1.f / (64.f * 64.f);
constexpr float AB_SCALE = 128.f, WAB_SCALE = 64.f;
constexpr float W2_SCALE = 32.0f, HID_SCALE = 16.0f, Y_DESCALE = 1.0f / (32.0f * 16.0f), Y8_SCALE = 16.0f;
constexpr int MOE_ROWS = 90112;

typedef __bf16 bf16x2_t __attribute__((ext_vector_type(2)));
__device__ __forceinline__ unsigned cvt_pk_bf16(float lo, float hi) { const f32x2 v = {lo, hi}; const bf16x2_t b = __builtin_convertvector(v, bf16x2_t); return __builtin_bit_cast(unsigned, b); }
__device__ __forceinline__ u32x4 pack8(f32x4 a, f32x4 b) { u32x4 w; w.x = cvt_pk_bf16(a[0], a[1]); w.y = cvt_pk_bf16(a[2], a[3]); w.z = cvt_pk_bf16(b[0], b[1]); w.w = cvt_pk_bf16(b[2], b[3]); return w; }
__device__ __forceinline__ float bf_lo(unsigned w) { return __uint_as_float(w << 16); }
__device__ __forceinline__ float bf_hi(unsigned w) { return __uint_as_float(w & 0xffff0000u); }
__device__ __forceinline__ void unpack8(u32x4 w, f32x4& a, f32x4& b) { a[0] = bf_lo(w.x); a[1] = bf_hi(w.x); a[2] = bf_lo(w.y); a[3] = bf_hi(w.y); b[0] = bf_lo(w.z); b[1] = bf_hi(w.z); b[2] = bf_lo(w.w); b[3] = bf_hi(w.w); }
__device__ __forceinline__ unsigned f2bf(float f) { unsigned u = __float_as_uint(f); return (u + 0x7fffu + ((u >> 16) & 1u)) >> 16; }
__device__ __forceinline__ float bf2f(bf16_t h) { return __uint_as_float(((unsigned)h) << 16); }
__device__ __forceinline__ float fast_sigmoid(float x) { return __builtin_amdgcn_rcpf(1.0f + __builtin_amdgcn_exp2f(-1.4426950408889634f * x)); }

__device__ __forceinline__ int lane_id() { return (int)(threadIdx.x & 63u); }
namespace pg8 {
constexpr int BM = 256, BK = 64, HALF = 128, HTB = HALF * BK * 2, STAGE_BYTES = 8 * HTB, NXCD = 8, WGM = 8;
__host__ __device__ __forceinline__ int lds_byte(int r, int c) { const int st = (r >> 4) * 2 + (c >> 5), rr = r & 15, cc = c & 31, ob = rr * 64 + cc * 2; return st * 1024 + (ob ^ (((ob >> 9) & 1) << 5)); }
__host__ __device__ __forceinline__ void stage_rc(int b, int& R, int& C) { const int st = b / 1024, sb = b % 1024, swz = sb ^ (((sb >> 9) & 1) << 5); R = (st >> 1) * 16 + swz / 64; C = (st & 1) * 32 + (swz % 64) / 2; }
__host__ __device__ __forceinline__ int perm32(int rho) { const int n = rho >> 4, i = rho & 15; return 8 * (i >> 2) + 4 * n + (i & 3); }

struct Unit { int pm, pn, e, aux; };

struct StaticOrder {
    int nM, nN, nwg, G, c;
    __device__ void init(int M, int N, int G_, int c_) { nM = M / BM; nN = N / BM; nwg = nM * nN; G = G_; c = c_; }
    __device__ bool next(int i, Unit& u) const {
        const long L = (long)i * G + c; if (L >= nwg) return false;
        int wgid = (int)L; { const int q = nwg / NXCD, r = nwg % NXCD, xcd = wgid % NXCD, off = wgid / NXCD; wgid = (xcd < r ? xcd * (q + 1) : r * (q + 1) + (xcd - r) * q) + off; }
        const int nig = WGM * nN, gid = wgid / nig, fm = gid * WGM, gsz = (nM - fm) < WGM ? (nM - fm) : WGM;
        u.pm = fm + ((wgid % nig) % gsz); u.pn = (wgid % nig) / gsz; u.e = 0; u.aux = 0; return true;
    }
};
struct DenseSched {
    static constexpr bool GATHER = false;
    const char* A; const char* Bt; int K; StaticOrder o;
    __device__ __forceinline__ bool next(int i, Unit& u) const { return o.next(i, u); }
    __device__ __forceinline__ const char* a_tile(const Unit& u) const { return A + (size_t)u.pm * (BM * 2) * K; }
    __device__ __forceinline__ const char* b_tile(const Unit& u) const { return Bt + (size_t)u.pn * (BM * 2) * K; }
    __device__ __forceinline__ void a_voff(const Unit&, const int (&R)[2], const int (&C)[2], unsigned (&v)[2][2]) const {
#pragma unroll
        for (int h = 0; h < 2; ++h)
#pragma unroll
            for (int i = 0; i < 2; ++i) v[h][i] = (unsigned)((R[i] + HALF * h) * K + C[i]) * 2u;
    }
};
struct DenseSched8 {
    static constexpr bool GATHER = false;
    const char* A; const char* Bt; int K; StaticOrder o;
    __device__ __forceinline__ bool next(int i, Unit& u) const { return o.next(i, u); }
    __device__ __forceinline__ const char* a_tile(const Unit& u) const { return A + (size_t)u.pm * BM * K; }
    __device__ __forceinline__ const char* b_tile(const Unit& u) const { return Bt + (size_t)u.pn * BM * K; }
    __device__ __forceinline__ void a_voff(const Unit&, const int (&R)[2], const int (&C)[2], unsigned (&v)[2][2]) const {
#pragma unroll
        for (int h = 0; h < 2; ++h)
#pragma unroll
            for (int i = 0; i < 2; ++i) v[h][i] = (unsigned)((R[i] + HALF * h) * K + C[i] * 2);
    }
};
typedef int v8i32 __attribute__((ext_vector_type(8)));
typedef short s16x16 __attribute__((ext_vector_type(16)));
__device__ __forceinline__ v8i32 cat16(bf16x8 lo, bf16x8 hi) { const s16x16 c = __builtin_shufflevector(lo, hi, 0, 1, 2, 3, 4, 5, 6, 7, 8, 9, 10, 11, 12, 13, 14, 15); return __builtin_bit_cast(v8i32, c); }

template <class Epi, class Sched, bool ALIGN_EPI, bool FP8 = false>
__device__ __forceinline__ void gemm_phase(LAS unsigned char* lds, const int KB, const Sched& S, const Epi& E, const int tid) {
    const int wid = __builtin_amdgcn_readfirstlane(tid >> 6), lane = tid & 63, wr = wid >> 2, wc = wid & 3, fr = lane & 15, fq = lane >> 4;
    const int nt = KB / (BK * 2);
    int Rr[2], Cc[2]; unsigned voffB[2];
#pragma unroll
    for (int i = 0; i < 2; ++i) { int R, C; stage_rc(tid * 16 + i * 8192, R, C); Rr[i] = R; Cc[i] = C; const int Rb = (R & ~31) + perm32(R & 31); voffB[i] = (unsigned)(Rb * KB + C * 2); }
    const size_t kstep = (size_t)(BK * 2);
    const size_t hstep = (size_t)HALF * KB;
    const unsigned ldsw = (unsigned)wid * 1024u;
    const int aoff = lds_byte(wr * 64 + fr, fq * 8), boff = lds_byte(wc * 32 + fr, fq * 8);
#define PG8_SA(b, h) (((b) * 2 + (h)) * HTB)
#define PG8_SB(b, h) ((4 + (b) * 2 + (h)) * HTB)
#define PG8_STAGE(bufoff, gbase, voff) do { _Pragma("unroll") for (int _i = 0; _i < 2; ++_i) \
        __builtin_amdgcn_global_load_lds((const unsigned*)((const char*)(gbase) + (voff)[_i]), (LAS unsigned*)(lds + (bufoff) + ldsw + _i * 8192), 16, 0, 0); } while (0)
#define PG8_LDA(dst, b, h) do { _Pragma("unroll") for (int m = 0; m < 4; ++m) dst[m] = cat16(*(const LAS bf16x8*)(lds + PG8_SA(b, h) + aoff + m * 2048), *(const LAS bf16x8*)(lds + PG8_SA(b, h) + aoff + m * 2048 + 1024)); } while (0)
#define PG8_LDB(dst, b, h) do { _Pragma("unroll") for (int n = 0; n < 2; ++n) dst[n] = cat16(*(const LAS bf16x8*)(lds + PG8_SB(b, h) + boff + n * 2048), *(const LAS bf16x8*)(lds + PG8_SB(b, h) + boff + n * 2048 + 1024)); } while (0)
#define PG8_LO(x) __builtin_bit_cast(bf16x8, __builtin_shufflevector(x, x, 0, 1, 2, 3))
#define PG8_HI(x) __builtin_bit_cast(bf16x8, __builtin_shufflevector(x, x, 4, 5, 6, 7))
#define PG8_MMA(ai, bj, At, Bt) do { __builtin_amdgcn_s_setprio(1); \
        if constexpr (FP8) { _Pragma("unroll") for (int m = 0; m < 4; ++m) _Pragma("unroll") for (int n = 0; n < 2; ++n) \
            asm volatile("v_mfma_scale_f32_16x16x128_f8f6f4 %0, %1, %2, %0, %3, %3 op_sel_hi:[0,0,0]" : "+v"(acc[ai][bj][m][n]) : "v"(Bt[n]), "v"(At[m]), "v"(one_scale)); } \
        else { _Pragma("unroll") for (int m = 0; m < 4; ++m) _Pragma("unroll") for (int n = 0; n < 2; ++n) { \
            acc[ai][bj][m][n] = __builtin_amdgcn_mfma_f32_16x16x32_bf16(PG8_LO(Bt[n]), PG8_LO(At[m]), acc[ai][bj][m][n], 0, 0, 0); \
            acc[ai][bj][m][n] = __builtin_amdgcn_mfma_f32_16x16x32_bf16(PG8_HI(Bt[n]), PG8_HI(At[m]), acc[ai][bj][m][n], 0, 0, 0); } } \
        __builtin_amdgcn_s_setprio(0); } while (0)
#define PG8_WAIT_V(n) asm volatile("s_waitcnt vmcnt(" #n ")" ::: "memory")
#define PG8_WAIT_L(n) asm volatile("s_waitcnt lgkmcnt(" #n ")" ::: "memory")
#define PG8_BAR __builtin_amdgcn_s_barrier()
#define PG8_SCHED __builtin_amdgcn_sched_barrier(0)
    Unit cur, nxt; int ui = 0;
    if (!S.next(0, cur)) return;
    f32x4 acc[2][2][4][2];
#pragma unroll
    for (int a = 0; a < 2; ++a)
#pragma unroll
        for (int b = 0; b < 2; ++b)
#pragma unroll
            for (int m = 0; m < 4; ++m)
#pragma unroll
                for (int n = 0; n < 2; ++n) acc[a][b][m][n] = (f32x4){0.f, 0.f, 0.f, 0.f};
    v8i32 At[4], B0[2], B1[2];
    const int one_scale = 0x7f7f7f7f; (void)one_scale;
    unsigned vA[2][2], vN[2][2];
    S.a_voff(cur, Rr, Cc, vA);
    const char* cA = S.a_tile(cur); const char* cB = S.b_tile(cur);
    PG8_STAGE(PG8_SB(0, 0), cB, voffB); PG8_STAGE(PG8_SB(0, 1), cB + hstep, voffB); PG8_STAGE(PG8_SA(0, 0), cA, vA[0]); PG8_STAGE(PG8_SA(0, 1), cA, vA[1]);
    if (wr == 1) PG8_BAR;
    PG8_WAIT_V(2); PG8_BAR;
    PG8_STAGE(PG8_SB(1, 0), cB + kstep, voffB); PG8_STAGE(PG8_SA(1, 0), cA + kstep, vA[0]); PG8_STAGE(PG8_SB(1, 1), cB + hstep + kstep, voffB);
    PG8_WAIT_V(6); PG8_BAR;
    for (;;) {
        const bool has_next = S.next(ui + 1, nxt);
        const char* nA = cA; const char* nB = cB;
        if constexpr (Sched::GATHER) {
#pragma unroll
            for (int h = 0; h < 2; ++h)
#pragma unroll
                for (int i = 0; i < 2; ++i) vN[h][i] = vA[h][i];
        }
        if (has_next) { nA = S.a_tile(nxt); nB = S.b_tile(nxt); if constexpr (Sched::GATHER) S.a_voff(nxt, Rr, Cc, vN); }
#pragma unroll 1
        for (int t = 0; t < nt; t += 2) {
            const bool last = (t == nt - 2);
            if constexpr (Epi::MID_T > 0) { if (t == Epi::MID_T) { int fr_ = fr, fq_ = fq; asm volatile("" : "+v"(fr_), "+v"(fq_)); E.mid(acc, cur, wr, wc, fr_, fq_); } }
            const char* a1 = cA + (size_t)(t + 1) * kstep;
            const char* a2 = last ? nA : cA + (size_t)(t + 2) * kstep; const char* b2 = last ? nB : cB + (size_t)(t + 2) * kstep;
            const char* a3 = a2 + kstep; const char* b3 = b2 + kstep;
            unsigned v2[2][2];
#pragma unroll
            for (int h = 0; h < 2; ++h)
#pragma unroll
                for (int i = 0; i < 2; ++i) { if constexpr (Sched::GATHER) v2[h][i] = last ? vN[h][i] : vA[h][i]; else v2[h][i] = vA[h][i]; }
            PG8_LDB(B0, 0, 0); PG8_LDB(B1, 0, 1); PG8_SCHED; PG8_LDA(At, 0, 0); PG8_STAGE(PG8_SA(1, 1), a1, vA[1]);
            PG8_WAIT_V(8); PG8_WAIT_L(0); PG8_BAR; PG8_MMA(0, 0, At, B0); PG8_MMA(0, 1, At, B1); PG8_BAR; PG8_SCHED;
            PG8_LDA(At, 0, 1); PG8_STAGE(PG8_SB(0, 0), b2, voffB); PG8_STAGE(PG8_SB(0, 1), b2 + hstep, voffB); PG8_STAGE(PG8_SA(0, 0), a2, v2[0]);
            PG8_WAIT_V(8); PG8_WAIT_L(0); PG8_BAR; PG8_MMA(1, 0, At, B0); PG8_MMA(1, 1, At, B1); PG8_BAR; PG8_SCHED;
            PG8_LDB(B0, 1, 0); PG8_LDB(B1, 1, 1); PG8_SCHED; PG8_LDA(At, 1, 0); PG8_STAGE(PG8_SA(0, 1), a2, v2[1]);
            PG8_WAIT_V(8); PG8_WAIT_L(0); PG8_BAR; PG8_MMA(0, 0, At, B0); PG8_MMA(0, 1, At, B1); PG8_BAR; PG8_SCHED;
            PG8_LDA(At, 1, 1); PG8_STAGE(PG8_SB(1, 0), b3, voffB); PG8_STAGE(PG8_SB(1, 1), b3 + hstep, voffB); PG8_STAGE(PG8_SA(1, 0), a3, v2[0]);
            PG8_WAIT_V(8); PG8_WAIT_L(0); PG8_BAR; PG8_MMA(1, 0, At, B0); PG8_MMA(1, 1, At, B1); PG8_BAR; PG8_SCHED;
        }
        if constexpr (ALIGN_EPI) { if (wr == 0) PG8_BAR; }
        if constexpr (FP8) asm volatile("s_nop 15\n\ts_nop 15" ::: "memory");
        if constexpr (Epi::PRE != 1.0f) {
#pragma unroll
            for (int a = 0; a < 2; ++a)
#pragma unroll
                for (int b = 0; b < 2; ++b)
#pragma unroll
                    for (int m = 0; m < 4; ++m)
#pragma unroll
                        for (int n = 0; n < 2; ++n) acc[a][b][m][n] *= Epi::PRE; }
        { int fr_ = fr, fq_ = fq; asm volatile("" : "+v"(fr_), "+v"(fq_));
          E(acc, cur, wr, wc, fr_, fq_); }
        if (!has_next) break;
#pragma unroll
        for (int a = 0; a < 2; ++a)
#pragma unroll
            for (int b = 0; b < 2; ++b)
#pragma unroll
                for (int m = 0; m < 4; ++m)
#pragma unroll
                    for (int n = 0; n < 2; ++n) acc[a][b][m][n] = (f32x4){0.f, 0.f, 0.f, 0.f};
        cur = nxt; cA = nA; cB = nB; ++ui;
        if constexpr (Sched::GATHER) {
#pragma unroll
            for (int h = 0; h < 2; ++h)
#pragma unroll
                for (int i = 0; i < 2; ++i) vA[h][i] = vN[h][i];
        }
        if constexpr (ALIGN_EPI) { if (wr == 1) PG8_BAR; }
    }
    PG8_WAIT_V(0);
    if constexpr (!ALIGN_EPI) { if (wr == 0) PG8_BAR; }
    PG8_BAR;
#undef PG8_SA
#undef PG8_SB
#undef PG8_STAGE
#undef PG8_LDA
#undef PG8_LDB
#undef PG8_LO
#undef PG8_HI
#undef PG8_MMA
#undef PG8_WAIT_V
#undef PG8_WAIT_L
#undef PG8_BAR
#undef PG8_SCHED
}

#define EPI_LOOP_ROWS for (int ai = 0; ai < 2; ++ai) _Pragma("unroll") for (int m = 0; m < 4; ++m)
struct EpiProj {
    static constexpr int MID_T = 0; static constexpr float PRE = 1.0f / WG_SCALE;
    bf16_t* O; const float* bgate; const float* ropeA; const float* ropeB; const float* qg; const float* kg; LAS float* xs; unsigned char* vt; unsigned char* k8;
    __device__ __forceinline__ void operator()(const f32x4 (&acc)[2][2][4][2], const Unit& u, int wr, int wc, int fr, int fq) const {
        const int row0 = u.pm * BM + wr * 64 + fr, colt = u.pn * BM, c0 = colt + wc * 32 + 8 * fq;
        if (colt >= GATE_OFF) {
            f32x4 bv[2][2];
#pragma unroll
            for (int bj = 0; bj < 2; ++bj)
#pragma unroll
                for (int n = 0; n < 2; ++n) bv[bj][n] = *(const f32x4*)(bgate + (c0 - GATE_OFF) + bj * HALF + 4 * n);
#pragma unroll
            EPI_LOOP_ROWS { bf16_t* rowp = O + (size_t)(row0 + ai * HALF + m * 16) * IN_COLS + c0;
#pragma unroll
                for (int bj = 0; bj < 2; ++bj) { f32x4 v0 = acc[ai][bj][m][0] + bv[bj][0], v1 = acc[ai][bj][m][1] + bv[bj][1];
#pragma unroll
                    for (int j = 0; j < 4; ++j) { v0[j] = fast_sigmoid(v0[j]); v1[j] = fast_sigmoid(v1[j]); }
                    *(u32x4*)(rowp + bj * HALF) = pack8(v0, v1); } }
        } else if (colt >= BQ_OFF && colt < BV_OFF) {
#pragma unroll
            EPI_LOOP_ROWS {
#pragma unroll
                for (int bj = 0; bj < 2; ++bj) { const f32x4 a0 = acc[ai][bj][m][0], a1 = acc[ai][bj][m][1];
                    float sq = (a0[0] * a0[0] + a0[1] * a0[1]) + (a0[2] * a0[2] + a0[3] * a0[3]) + (a1[0] * a1[0] + a1[1] * a1[1]) + (a1[2] * a1[2] + a1[3] * a1[3]);
                    sq += __uint_as_float((unsigned)__builtin_amdgcn_ds_swizzle((int)__float_as_uint(sq), (16 << 10) | 0x1f));
                    { auto rr = __builtin_amdgcn_permlane32_swap(__float_as_uint(sq), __float_as_uint(sq), false, false); sq = __uint_as_float(rr[0]) + __uint_as_float(rr[1]); }
                    if (fq == 0) xs[((ai * HALF + wr * 64 + m * 16 + fr) * 2 + bj) * 4 + wc] = sq; } }
            asm volatile("s_waitcnt lgkmcnt(0)" ::: "memory"); __builtin_amdgcn_s_barrier(); asm volatile("" ::: "memory");
            const int half = wc >> 1, jb = 16 * (wc & 1) + 4 * fq;
            const float* gn = (colt >= BK_OFF) ? kg : qg;
            const f32x4 g1 = *(const f32x4*)(gn + 64 * half + jb), g2 = *(const f32x4*)(gn + 64 * half + 32 + jb);
#pragma unroll
            EPI_LOOP_ROWS { const int row = row0 + ai * HALF + m * 16, t = row & (SEQ - 1), pos = half ? (t & 63) : (t >> 6);
                const f32x4 cs0 = *(const f32x4*)(ropeB + ((size_t)pos * 32 + jb) * 2), cs1 = *(const f32x4*)(ropeB + ((size_t)pos * 32 + jb) * 2 + 4);
                bf16_t* rowp = O + (size_t)row * IN_COLS + c0;
#pragma unroll
                for (int bj = 0; bj < 2; ++bj) { const f32x4 p = *(const LAS f32x4*)(xs + ((ai * HALF + wr * 64 + m * 16 + fr) * 2 + bj) * 4);
                    const float rstd = 1.0f / sqrtf(((p[0] + p[1]) + (p[2] + p[3])) * (1.f / HD) + EPS);
                    const f32x4 a0 = acc[ai][bj][m][0] * rstd, a1 = acc[ai][bj][m][1] * rstd; f32x4 o0, o1;
                    { const float x1 = a0[0] * g1[0], x2 = a0[1] * g2[0]; o0[0] = x1 * cs0[0] - x2 * cs0[1]; o0[1] = x2 * cs0[0] + x1 * cs0[1]; }
                    { const float x1 = a0[2] * g1[1], x2 = a0[3] * g2[1]; o0[2] = x1 * cs0[2] - x2 * cs0[3]; o0[3] = x2 * cs0[2] + x1 * cs0[3]; }
                    { const float x1 = a1[0] * g1[2], x2 = a1[1] * g2[2]; o1[0] = x1 * cs1[0] - x2 * cs1[1]; o1[1] = x2 * cs1[0] + x1 * cs1[1]; }
                    { const float x1 = a1[2] * g1[3], x2 = a1[3] * g2[3]; o1[2] = x1 * cs1[2] - x2 * cs1[3]; o1[3] = x2 * cs1[2] + x1 * cs1[3]; }
                    if (colt >= BK_OFF) {
                        unsigned lo = 0, hi8 = 0;
                        lo = __builtin_amdgcn_cvt_pk_fp8_f32(o0[0], o0[1], lo, false); lo = __builtin_amdgcn_cvt_pk_fp8_f32(o0[2], o0[3], lo, true);
                        hi8 = __builtin_amdgcn_cvt_pk_fp8_f32(o1[0], o1[1], hi8, false); hi8 = __builtin_amdgcn_cvt_pk_fp8_f32(o1[2], o1[3], hi8, true);
                        *(u32x2*)(k8 + ((size_t)((row / SEQ) * 4 + (colt - BK_OFF) / HD + bj) * SEQ + (row & (SEQ - 1))) * HD + wc * 32 + 8 * fq) = (u32x2){lo, hi8}; }
                    else *(u32x4*)(rowp + bj * HALF) = pack8(o0, o1); } }
        } else {
            if (colt >= BV_OFF) {
#pragma unroll
                EPI_LOOP_ROWS { const int row = row0 + ai * HALF + m * 16;
                    unsigned char* vp = vt + ((size_t)((row / SEQ) * 4 + (colt - BV_OFF) / HD) * HD + wc * 32 + 8 * fq) * SEQ + (row & (SEQ - 1));
#pragma unroll
                    for (int bj = 0; bj < 2; ++bj)
#pragma unroll
                        for (int n = 0; n < 2; ++n) { const f32x4 v = acc[ai][bj][m][n];
                            const unsigned w0 = __builtin_amdgcn_cvt_pk_fp8_f32(v[0], v[1], 0u, false), w1 = __builtin_amdgcn_cvt_pk_fp8_f32(v[2], v[3], 0u, false);
                            unsigned char* q = vp + (size_t)(bj * HD + 4 * n) * SEQ;
                            q[0] = (unsigned char)(w0 & 0xffu); q[SEQ] = (unsigned char)((w0 >> 8) & 0xffu); q[2 * SEQ] = (unsigned char)(w1 & 0xffu); q[3 * SEQ] = (unsigned char)((w1 >> 8) & 0xffu); } }
                return; }
            const bool ropea = colt < A_COLS && (u.pn % 6) < 4 && wc == 0;
#pragma unroll
            EPI_LOOP_ROWS { const int row = row0 + ai * HALF + m * 16; bf16_t* rowp = O + (size_t)row * IN_COLS + c0;
                f32x4 cs0 = {1.f, 0.f, 1.f, 0.f}, cs1 = {1.f, 0.f, 1.f, 0.f};
                if (ropea) { const int t = row & (SEQ - 1); cs0 = *(const f32x4*)(ropeA + ((size_t)t * 16 + 4 * fq) * 2); cs1 = *(const f32x4*)(ropeA + ((size_t)t * 16 + 4 * fq) * 2 + 4); }
#pragma unroll
                for (int bj = 0; bj < 2; ++bj) { const f32x4 a0 = acc[ai][bj][m][0], a1 = acc[ai][bj][m][1]; f32x4 o0, o1;
                    o0[0] = a0[0] * cs0[0] - a0[1] * cs0[1]; o0[1] = a0[1] * cs0[0] + a0[0] * cs0[1]; o0[2] = a0[2] * cs0[2] - a0[3] * cs0[3]; o0[3] = a0[3] * cs0[2] + a0[2] * cs0[3];
                    o1[0] = a1[0] * cs1[0] - a1[1] * cs1[1]; o1[1] = a1[1] * cs1[0] + a1[0] * cs1[1]; o1[2] = a1[2] * cs1[2] - a1[3] * cs1[3]; o1[3] = a1[3] * cs1[2] + a1[2] * cs1[3];
                    *(u32x4*)(rowp + bj * HALF) = pack8(o0, o1); } }
        }
    }
};
struct EpiGate {
    static constexpr int MID_T = 0; static constexpr float PRE = 1.0f;
    bf16_t* O; const float* bgate;
    __device__ __forceinline__ void operator()(const f32x4 (&acc)[2][2][4][2], const Unit& u, int wr, int wc, int fr, int fq) const {
        const int row0 = u.pm * BM + wr * 64 + fr, c0 = u.pn * BM + wc * 32 + 8 * fq;
        f32x4 bv[2][2];
#pragma unroll
        for (int bj = 0; bj < 2; ++bj)
#pragma unroll
            for (int n = 0; n < 2; ++n) bv[bj][n] = *(const f32x4*)(bgate + c0 + bj * HALF + 4 * n);
#pragma unroll
        EPI_LOOP_ROWS { bf16_t* rowp = O + (size_t)(row0 + ai * HALF + m * 16) * IN_COLS + GATE_OFF + c0;
#pragma unroll
            for (int bj = 0; bj < 2; ++bj) { f32x4 v0 = acc[ai][bj][m][0] * WG_DESCALE + bv[bj][0], v1 = acc[ai][bj][m][1] * WG_DESCALE + bv[bj][1];
#pragma unroll
                for (int j = 0; j < 4; ++j) { v0[j] = fast_sigmoid(v0[j]); v1[j] = fast_sigmoid(v1[j]); }
                *(u32x4*)(rowp + bj * HALF) = pack8(v0, v1); } }
    }
};
struct EpiMerged2 {
    static constexpr int MID_T = 4; static constexpr float PRE = 1.0f;
    unsigned char* O; const bf16_t* P;
    __device__ __forceinline__ void mid(f32x4 (&acc)[2][2][4][2], const Unit& u, int wr, int wc, int fr, int fq) const {
        const int row0 = u.pm * BM + wr * 64 + fr, c0 = u.pn * BM + wc * 32 + 8 * fq;
#pragma unroll
        EPI_LOOP_ROWS { const size_t r = (size_t)(row0 + ai * HALF + m * 16);
#pragma unroll
            for (int bj = 0; bj < 2; ++bj) { const int c = c0 + bj * HALF; f32x4 a0, a1, b0, b1;
                unpack8(*(const u32x4*)(P + r * IN_COLS + GATE_OFF + c), a0, a1); unpack8(*(const u32x4*)(P + r * IN_COLS + GATE_OFF + DM + c), b0, b1);
#pragma unroll
                for (int j = 0; j < 4; ++j) { acc[ai][bj][m][0][j] *= a0[j] * __builtin_amdgcn_rcpf(fmaxf(b0[j], 1e-30f)); acc[ai][bj][m][1][j] *= a1[j] * __builtin_amdgcn_rcpf(fmaxf(b1[j], 1e-30f)); } } }
    }
    __device__ __forceinline__ void operator()(const f32x4 (&acc)[2][2][4][2], const Unit& u, int wr, int wc, int fr, int fq) const {
        const int row0 = u.pm * BM + wr * 64 + fr, c0 = u.pn * BM + wc * 32 + 8 * fq;
        constexpr float MGS = MG_SCALE / (AB_SCALE * WAB_SCALE);
#pragma unroll
        for (int ai = 0; ai < 2; ++ai)
#pragma unroll
            for (int mp = 0; mp < 2; ++mp)
#pragma unroll
                for (int bj = 0; bj < 2; ++bj) { const int c = c0 + bj * HALF; unsigned w[2][2];
#pragma unroll
                    for (int k = 0; k < 2; ++k) { const int m = 2 * mp + k; const size_t r = (size_t)(row0 + ai * HALF + m * 16);
                        f32x4 g0, g1; unpack8(*(const u32x4*)(P + r * IN_COLS + GATE_OFF + DM + c), g0, g1);
#pragma unroll
                        for (int j = 0; j < 4; ++j) { g0[j] = fmaxf(g0[j], 1e-30f); g1[j] = fmaxf(g1[j], 1e-30f); }
                        f32x4 v0 = acc[ai][bj][m][0] * g0 * MGS, v1 = acc[ai][bj][m][1] * g1 * MGS; unsigned lo = 0, hi = 0;
#pragma unroll
                        for (int j = 0; j < 4; ++j) { v0[j] = __builtin_amdgcn_fmed3f(v0[j], -448.f, 448.f); v1[j] = __builtin_amdgcn_fmed3f(v1[j], -448.f, 448.f); }
                        lo = __builtin_amdgcn_cvt_pk_fp8_f32(v0[0], v0[1], lo, false); lo = __builtin_amdgcn_cvt_pk_fp8_f32(v0[2], v0[3], lo, true);
                        hi = __builtin_amdgcn_cvt_pk_fp8_f32(v1[0], v1[1], hi, false); hi = __builtin_amdgcn_cvt_pk_fp8_f32(v1[2], v1[3], hi, true);
                        w[k][0] = lo; w[k][1] = hi; }
                    const int od = fq & 1;
                    const auto s0 = __builtin_amdgcn_permlane16_swap(w[0][0], w[1][0], false, false), s1 = __builtin_amdgcn_permlane16_swap(w[0][1], w[1][1], false, false);
                    *(u32x4*)(O + (size_t)(row0 + ai * HALF + (2 * mp + od) * 16) * DM + c - 8 * od) = (u32x4){s0[0], s1[0], s0[1], s1[1]}; }
    }
};
struct EpiX1 {
    static constexpr int MID_T = 0; static constexpr float PRE = 1.0f;
    float* X1; const float* x; const float* mod;
    __device__ __forceinline__ void operator()(const f32x4 (&acc)[2][2][4][2], const Unit& u, int wr, int wc, int fr, int fq) const {
        const int row0 = u.pm * BM + wr * 64 + fr, c0 = u.pn * BM + wc * 32 + 8 * fq;
        const float* gt = mod + (size_t)((u.pm * BM) / SEQ) * (6 * DM) + 2 * DM;
        f32x4 gv[2][2];
#pragma unroll
        for (int bj = 0; bj < 2; ++bj)
#pragma unroll
            for (int n = 0; n < 2; ++n) gv[bj][n] = *(const f32x4*)(gt + c0 + bj * HALF + 4 * n) * X1_DESCALE;
#pragma unroll
        EPI_LOOP_ROWS { const size_t r = (size_t)(row0 + ai * HALF + m * 16);
#pragma unroll
            for (int bj = 0; bj < 2; ++bj)
#pragma unroll
                for (int n = 0; n < 2; ++n) { const int c = c0 + bj * HALF + 4 * n; *(f32x4*)(X1 + r * DM + c) = *(const f32x4*)(x + r * DM + c) + gv[bj][n] * acc[ai][bj][m][n]; } }
    }
};
struct EpiHid {
    static constexpr int MID_T = 0; static constexpr float PRE = 1.0f;
    unsigned char* HID; const float* gate_of; LAS const int* cnt;
    __device__ __forceinline__ void operator()(const f32x4 (&acc)[2][2][4][2], const Unit& u, int wr, int wc, int fr, int fq) const {
        const int od = fq & 1;
        const int row0 = u.pm * BM + wr * 64 + fr, c0 = u.pn * HALF + wc * 32 + 8 * (fq - od);
        const int ce = cnt[u.e];
#pragma unroll
        for (int ai = 0; ai < 2; ++ai)
#pragma unroll
            for (int mp = 0; mp < 2; ++mp) { unsigned w[2][2];
#pragma unroll
                for (int k = 0; k < 2; ++k) { const int m = 2 * mp + k; const int rr = ai * HALF + m * 16; const int slot = u.aux + wr * 64 + fr + rr;
                    float g = HID_SCALE; if (u.e < NE) g = slot < ce ? gate_of[(size_t)u.e * ECAP + slot] * HID_SCALE : 0.f;
                    f32x4 h0, h1;
#pragma unroll
                    for (int j = 0; j < 4; ++j) { const float a0 = acc[ai][0][m][0][j] * W13_DESCALE, a1 = acc[ai][0][m][1][j] * W13_DESCALE;
                        h0[j] = g * a0 * fast_sigmoid(a0) * (acc[ai][1][m][0][j] * W13_DESCALE); h1[j] = g * a1 * fast_sigmoid(a1) * (acc[ai][1][m][1][j] * W13_DESCALE); }
#pragma unroll
                    for (int j = 0; j < 4; ++j) { h0[j] = __builtin_amdgcn_fmed3f(h0[j], -448.f, 448.f); h1[j] = __builtin_amdgcn_fmed3f(h1[j], -448.f, 448.f); }
                    unsigned lo = 0, hi = 0;
                    lo = __builtin_amdgcn_cvt_pk_fp8_f32(h0[0], h0[1], lo, false); lo = __builtin_amdgcn_cvt_pk_fp8_f32(h0[2], h0[3], lo, true);
                    hi = __builtin_amdgcn_cvt_pk_fp8_f32(h1[0], h1[1], hi, false); hi = __builtin_amdgcn_cvt_pk_fp8_f32(h1[2], h1[3], hi, true);
                    w[k][0] = lo; w[k][1] = hi; }
                const auto s0 = __builtin_amdgcn_permlane16_swap(w[0][0], w[1][0], false, false), s1 = __builtin_amdgcn_permlane16_swap(w[0][1], w[1][1], false, false);
                *(u32x4*)(HID + (size_t)(row0 + ai * HALF + (2 * mp + od) * 16) * DE + c0) = (u32x4){s0[0], s1[0], s0[1], s1[1]}; }
    }
};
struct EpiY {
    static constexpr int MID_T = 0; static constexpr float PRE = 1.0f;
    unsigned char* Y;
    __device__ __forceinline__ void operator()(const f32x4 (&acc)[2][2][4][2], const Unit& u, int wr, int wc, int fr, int fq) const {
        const int od = fq & 1;
        const int row0 = u.pm * BM + wr * 64 + fr + 16 * od, c0 = u.pn * BM + wc * 32 + 8 * (fq - od);
        constexpr float sc = Y_DESCALE * Y8_SCALE;
#pragma unroll
        for (int ai = 0; ai < 2; ++ai)
#pragma unroll
            for (int mp = 0; mp < 2; ++mp) { unsigned char* rowp = Y + (size_t)(row0 + ai * HALF + mp * 32) * DM + c0;
#pragma unroll
                for (int bj = 0; bj < 2; ++bj) { unsigned w[2][2];
#pragma unroll
                    for (int k = 0; k < 2; ++k) { f32x4 v0 = acc[ai][bj][2 * mp + k][0] * sc, v1 = acc[ai][bj][2 * mp + k][1] * sc; unsigned lo = 0, hi = 0;
#pragma unroll
                        for (int j = 0; j < 4; ++j) { v0[j] = __builtin_amdgcn_fmed3f(v0[j], -448.f, 448.f); v1[j] = __builtin_amdgcn_fmed3f(v1[j], -448.f, 448.f); }
                        lo = __builtin_amdgcn_cvt_pk_fp8_f32(v0[0], v0[1], lo, false); lo = __builtin_amdgcn_cvt_pk_fp8_f32(v0[2], v0[3], lo, true);
                        hi = __builtin_amdgcn_cvt_pk_fp8_f32(v1[0], v1[1], hi, false); hi = __builtin_amdgcn_cvt_pk_fp8_f32(v1[2], v1[3], hi, true);
                        w[k][0] = lo; w[k][1] = hi; }
                    const auto s0 = __builtin_amdgcn_permlane16_swap(w[0][0], w[1][0], false, false), s1 = __builtin_amdgcn_permlane16_swap(w[0][1], w[1][1], false, false);
                    *(u32x4*)(rowp + bj * HALF) = (u32x4){s0[0], s1[0], s0[1], s1[1]}; } }
    }
};
}

namespace att {
constexpr int D = 128, NW = 8, QBLK = 32, KVBLK = 64;
constexpr float SCALE = 0.088388347648318440f;
constexpr float THR = 8.f;
constexpr size_t SHM_V = KVBLK * D * 2, SHM_K = KVBLK * D * 2, SHM_ATTN = 2 * SHM_V + 2 * SHM_K + NW * 64 * 4;
#define KSWZ(row, colB) ((row) * 256 + ((colB) ^ (((row) & 7) << 4)))
#define SBAR() __builtin_amdgcn_sched_barrier(0)
__device__ __forceinline__ int crow(int r, int hi) { return (r & 3) + 8 * (r >> 2) + 4 * hi; }
__device__ __forceinline__ unsigned cvtpk(float lo, float hi) { return cvt_pk_bf16(lo, hi); }

__device__ __forceinline__ void mask_tile(f32x16& p0, f32x16& p1, int dq) {
    const float NEG = -__builtin_inff();
#pragma unroll
    for (int r = 0; r < 16; ++r) { const int c = (r & 3) + 8 * (r >> 2);
        if ((unsigned)(dq - c + 64) > 128u) p0[r] = NEG;
        if ((unsigned)(dq - c - 32 + 64) > 128u) p1[r] = NEG; }
}
__device__ __forceinline__ void partialSM(f32x16& p0, f32x16& p1, float& m_reg, float& mn, float& alpha, const float thr = THR) {
    constexpr float C = SCALE * 1.4426950408889634f;
    float pmax = p0[0];
#pragma unroll
    for (int r = 1; r < 16; ++r) pmax = fmaxf(pmax, p0[r]);
#pragma unroll
    for (int r = 0; r < 16; ++r) pmax = fmaxf(pmax, p1[r]);
    { auto rr = __builtin_amdgcn_permlane32_swap(__float_as_uint(pmax), __float_as_uint(pmax), false, false);
      pmax = fmaxf(__uint_as_float(rr[0]), __uint_as_float(rr[1])); }
    if (__builtin_expect(__all(pmax - m_reg <= thr / SCALE), 1)) { mn = m_reg; alpha = 1.f; }
    else { mn = fmaxf(m_reg, pmax); alpha = __builtin_amdgcn_exp2f((m_reg - mn) * C); m_reg = mn; }
    const float mnC = -mn * C;
#pragma unroll
    for (int r = 0; r < 16; ++r) p0[r] = fmaf(p0[r], C, mnC);
#pragma unroll
    for (int r = 0; r < 16; ++r) p1[r] = fmaf(p1[r], C, mnC);
#pragma unroll
    for (int r = 0; r < 16; ++r) p0[r] = __builtin_amdgcn_exp2f(p0[r]);
}
__device__ __forceinline__ void finishSM(f32x16& p0, f32x16& p1, float alpha, float& l_reg, bf16x8& pa0, bf16x8& pa1, bf16x8& pa2, bf16x8& pa3) {
#pragma unroll
    for (int r = 0; r < 16; ++r) p1[r] = __builtin_amdgcn_exp2f(p1[r]);
    float ps = 0;
#pragma unroll
    for (int r = 0; r < 16; ++r) ps += p0[r];
#pragma unroll
    for (int r = 0; r < 16; ++r) ps += p1[r];
    { auto rr = __builtin_amdgcn_permlane32_swap(__float_as_uint(ps), __float_as_uint(ps), false, false);
      ps = __uint_as_float(rr[0]) + __uint_as_float(rr[1]); }
    l_reg = l_reg * alpha + ps;
#define PK4(P, BASE, OUT) do { unsigned a0 = cvtpk(P[BASE + 0], P[BASE + 1]), a1 = cvtpk(P[BASE + 2], P[BASE + 3]);   \
    unsigned b0 = cvtpk(P[BASE + 4], P[BASE + 5]), b1 = cvtpk(P[BASE + 6], P[BASE + 7]);                              \
    auto r0 = __builtin_amdgcn_permlane32_swap(a0, b0, false, false); auto r1 = __builtin_amdgcn_permlane32_swap(a1, b1, false, false); \
    u32x4 w = {r0[0], r1[0], r0[1], r1[1]}; OUT = *reinterpret_cast<bf16x8*>(&w); } while (0)
    PK4(p0, 0, pa0); PK4(p0, 8, pa1); PK4(p1, 0, pa2); PK4(p1, 8, pa3);
#undef PK4
}
__device__ __forceinline__ void qkt(f32x16& p0, f32x16& p1, const bf16_t* Ks, const bf16x8* qr, int r32, int hi) {
    p0 = f32x16{}; p1 = f32x16{};
#pragma unroll
    for (int d0 = 0; d0 < 8; ++d0) { const int cb = (d0 * 16 + hi * 8) * 2;
        const bf16x8 b0 = *reinterpret_cast<const bf16x8*>((const char*)Ks + KSWZ(r32, cb));
        const bf16x8 b1 = *reinterpret_cast<const bf16x8*>((const char*)Ks + KSWZ(32 + r32, cb));
        p0 = __builtin_amdgcn_mfma_f32_32x32x16_bf16(b0, qr[d0], p0, 0, 0, 0);
        p1 = __builtin_amdgcn_mfma_f32_32x32x16_bf16(b1, qr[d0], p1, 0, 0, 0); }
}
#define KSWZ8(row, colB) ((row) * 128 + ((colB) ^ ((((row) >> 1) & 7) << 4)))
typedef int v8i32a __attribute__((ext_vector_type(8)));
template <int DUMMY = 0>
__device__ __forceinline__ void qkt8(f32x16& p0, f32x16& p1, const char* Ks, const v8i32a (&q8)[2], int r32, int hi) {
    p0 = f32x16{}; p1 = f32x16{};
    const int one_scale = 0x7f7f7f7f;
#pragma unroll
    for (int j = 0; j < 2; ++j) { const int cb = 64 * j + 32 * hi;
        const u32x4 a0l = *reinterpret_cast<const u32x4*>(Ks + KSWZ8(r32, cb)), a0h = *reinterpret_cast<const u32x4*>(Ks + KSWZ8(r32, cb + 16));
        const u32x4 a1l = *reinterpret_cast<const u32x4*>(Ks + KSWZ8(32 + r32, cb)), a1h = *reinterpret_cast<const u32x4*>(Ks + KSWZ8(32 + r32, cb + 16));
        const v8i32a a0 = {(int)a0l.x, (int)a0l.y, (int)a0l.z, (int)a0l.w, (int)a0h.x, (int)a0h.y, (int)a0h.z, (int)a0h.w};
        const v8i32a a1 = {(int)a1l.x, (int)a1l.y, (int)a1l.z, (int)a1l.w, (int)a1h.x, (int)a1h.y, (int)a1h.z, (int)a1h.w};
        asm volatile("v_mfma_scale_f32_32x32x64_f8f6f4 %0, %1, %2, %0, %3, %3 op_sel_hi:[0,0,0]" : "+v"(p0) : "v"(a0), "v"(q8[j]), "v"(one_scale));
        asm volatile("v_mfma_scale_f32_32x32x64_f8f6f4 %0, %1, %2, %0, %3, %3 op_sel_hi:[0,0,0]" : "+v"(p1) : "v"(a1), "v"(q8[j]), "v"(one_scale)); }
    asm volatile("s_nop 15\n\ts_nop 15" : "+v"(p0), "+v"(p1));
}
constexpr float THR8 = 6.f;
#define VSWZ(d, colB) ((d) * 64 + ((colB) ^ ((((d) >> 2) & 3) << 4)))
__device__ __forceinline__ unsigned f4_to_fp8(float a, float b, float c, float d) { unsigned r = 0; r = __builtin_amdgcn_cvt_pk_fp8_f32(a, b, r, false); r = __builtin_amdgcn_cvt_pk_fp8_f32(c, d, r, true); return r; }
__device__ __forceinline__ void finishSM8(f32x16& p0, f32x16& p1, float alpha, float& l_reg, v8i32a& P8) {
#pragma unroll
    for (int r = 0; r < 16; ++r) p1[r] = __builtin_amdgcn_exp2f(p1[r]);
    float ps = 0;
#pragma unroll
    for (int r = 0; r < 16; ++r) ps += p0[r];
#pragma unroll
    for (int r = 0; r < 16; ++r) ps += p1[r];
    { auto rr = __builtin_amdgcn_permlane32_swap(__float_as_uint(ps), __float_as_uint(ps), false, false);
      ps = __uint_as_float(rr[0]) + __uint_as_float(rr[1]); }
    l_reg = l_reg * alpha + ps;
    P8 = (v8i32a){(int)f4_to_fp8(p0[0], p0[1], p0[2], p0[3]), (int)f4_to_fp8(p0[4], p0[5], p0[6], p0[7]), (int)f4_to_fp8(p0[8], p0[9], p0[10], p0[11]), (int)f4_to_fp8(p0[12], p0[13], p0[14], p0[15]),
                  (int)f4_to_fp8(p1[0], p1[1], p1[2], p1[3]), (int)f4_to_fp8(p1[4], p1[5], p1[6], p1[7]), (int)f4_to_fp8(p1[8], p1[9], p1[10], p1[11]), (int)f4_to_fp8(p1[12], p1[13], p1[14], p1[15])};
}
template <int DUMMY = 0>
__device__ __forceinline__ void pv8(f32x16* o, const char* Vl, const v8i32a& P8, int r32, int hi) {
    const int one_scale = 0x7f7f7f7f;
    v8i32a b[4];
#pragma unroll
    for (int d0 = 0; d0 < 4; ++d0) { const int d = 32 * d0 + r32;
        const u32x4 lo = *reinterpret_cast<const u32x4*>(Vl + VSWZ(d, 32 * hi)), hh = *reinterpret_cast<const u32x4*>(Vl + VSWZ(d, 32 * hi + 16));
        b[d0] = (v8i32a){(int)lo.x, (int)lo.y, (int)lo.z, (int)lo.w, (int)hh.x, (int)hh.y, (int)hh.z, (int)hh.w}; }
#pragma unroll
    for (int d0 = 0; d0 < 4; ++d0)
        asm volatile("v_mfma_scale_f32_32x32x64_f8f6f4 %0, %1, %2, %0, %3, %3 op_sel_hi:[0,0,0]" : "+v"(o[d0]) : "v"(P8), "v"(b[d0]), "v"(one_scale));
    asm volatile("s_nop 15\n\ts_nop 15" : "+v"(o[0]), "+v"(o[1]), "+v"(o[2]), "+v"(o[3]));
}
__device__ __forceinline__ unsigned bf8x4_to_fp8(unsigned w0, unsigned w1) {
    unsigned r = 0; r = __builtin_amdgcn_cvt_pk_fp8_f32(bf_lo(w0), bf_hi(w0), r, false); r = __builtin_amdgcn_cvt_pk_fp8_f32(bf_lo(w1), bf_hi(w1), r, true); return r; }
__device__ __forceinline__ int v_st(int k, int c) { const int kk = (k & ~0xC) | ((k & 4) << 1) | ((k & 8) >> 1); return ((kk >> 3) * 4 + (c >> 5)) * 512 + ((kk & 7) * 32 + (c & 31)) * 2; }
__device__ __forceinline__ int v_rd_base(int lane) { return ((lane & 3) << 3) | (((lane >> 2) & 3) << 6) | (((lane >> 4) & 1) << 5) | (((lane >> 5) & 1) << 8); }
constexpr int v_rd_off(int d0, int ks, int half) { return d0 * 512 + ks * 4096 + half * 2048; }
template <int OFF> __device__ __forceinline__ s16x4 tr_read(int vb) {
    s16x4 r; asm volatile("ds_read_b64_tr_b16 %0, %1 offset:%2" : "=&v"(r) : "v"(vb), "i"(OFF) : "memory"); return r;
}
template <int D0> __device__ __forceinline__ void pv_one(f32x16& od, int vb, bf16x8 pa0, bf16x8 pa1, bf16x8 pa2, bf16x8 pa3) {
    const s16x4 l0 = tr_read<v_rd_off(D0, 0, 0)>(vb), h0 = tr_read<v_rd_off(D0, 0, 1)>(vb), l1 = tr_read<v_rd_off(D0, 1, 0)>(vb), h1 = tr_read<v_rd_off(D0, 1, 1)>(vb);
    const s16x4 l2 = tr_read<v_rd_off(D0, 2, 0)>(vb), h2 = tr_read<v_rd_off(D0, 2, 1)>(vb), l3 = tr_read<v_rd_off(D0, 3, 0)>(vb), h3 = tr_read<v_rd_off(D0, 3, 1)>(vb);
    asm volatile("s_waitcnt lgkmcnt(0)" ::: "memory"); SBAR();
#define PK(L, H) (bf16x8){L[0], L[1], L[2], L[3], H[0], H[1], H[2], H[3]}
    od = __builtin_amdgcn_mfma_f32_32x32x16_bf16(pa0, PK(l0, h0), od, 0, 0, 0);
    od = __builtin_amdgcn_mfma_f32_32x32x16_bf16(pa1, PK(l1, h1), od, 0, 0, 0);
    od = __builtin_amdgcn_mfma_f32_32x32x16_bf16(pa2, PK(l2, h2), od, 0, 0, 0);
    od = __builtin_amdgcn_mfma_f32_32x32x16_bf16(pa3, PK(l3, h3), od, 0, 0, 0);
#undef PK
}
__device__ __forceinline__ void pv_d0(f32x16* o, int vb, bf16x8 pa0, bf16x8 pa1, bf16x8 pa2, bf16x8 pa3) {
    pv_one<0>(o[0], vb, pa0, pa1, pa2, pa3); pv_one<1>(o[1], vb, pa0, pa1, pa2, pa3); pv_one<2>(o[2], vb, pa0, pa1, pa2, pa3); pv_one<3>(o[3], vb, pa0, pa1, pa2, pa3);
}

template <bool BAND, int LDQ, int LDO, int LSE_STRIDE>
__device__ __forceinline__ void attn_unit(const bf16_t* __restrict__ Qb, const bf16_t* __restrict__ Kh, const bf16_t* __restrict__ Vh, bf16_t* __restrict__ Ob,
                                          int NT, int qoff, float* __restrict__ lse_out, char* lds, const int tid) {
    constexpr int ldq = LDQ, ldk = LDQ, ldo = LDO, lse_stride = LSE_STRIDE;
    const int wid = tid >> 6, lane = tid & 63, r32 = lane & 31, hi = lane >> 5;
    bf16_t* V_lds = (bf16_t*)lds; bf16_t* K_lds = (bf16_t*)(lds + 2 * SHM_V);
    float* ws = (float*)(lds + 2 * SHM_V + 2 * SHM_K) + wid * 64; float* li_l = ws; float* al_l = ws + 32;
    float m_reg = -1e30f, l_reg = 0; f32x16 o[4] = {}; v8i32a qr[2];
    { const bf16_t* Qw = Qb + (size_t)((wid * QBLK + r32) * ldq + hi * 32);
#pragma unroll
      for (int j = 0; j < 2; ++j) { u32x4 t[4];
#pragma unroll
          for (int q = 0; q < 4; ++q) t[q] = *reinterpret_cast<const u32x4*>(Qw + 64 * j + 8 * q);
          qr[j] = (v8i32a){(int)bf8x4_to_fp8(t[0].x, t[0].y), (int)bf8x4_to_fp8(t[0].z, t[0].w), (int)bf8x4_to_fp8(t[1].x, t[1].y), (int)bf8x4_to_fp8(t[1].z, t[1].w),
                           (int)bf8x4_to_fp8(t[2].x, t[2].y), (int)bf8x4_to_fp8(t[2].z, t[2].w), (int)bf8x4_to_fp8(t[3].x, t[3].y), (int)bf8x4_to_fp8(t[3].z, t[3].w)}; } }
    const int sr = tid >> 4, sc = (tid & 15) * 8, vst0 = v_st(sr, sc), vst1 = v_st(32 + sr, sc);
    const int vb0 = (int)(uintptr_t)V_lds + v_rd_base(lane);
    const int dq0 = qoff + wid * QBLK + r32 - 4 * hi;
    struct { u32x4 vs, ks; } sr_[2];
    const int kkey = tid >> 3, kch = (tid & 7) * 16;
    const int vd = tid >> 2, vkc = (tid & 3) * 16;
    const unsigned lo0 = (unsigned)(sr * ldk + sc) * 2u, lo1 = lo0 + (unsigned)(32 * ldk * 2);
#define SLOAD(i, k0) do { sr_[i].vs = *reinterpret_cast<const u32x4*>((const char*)Vh + (size_t)vd * SEQ + (k0) + vkc); \
    sr_[i].ks = *reinterpret_cast<const u32x4*>((const char*)Kh + (size_t)((k0) + kkey) * HD + kch); } while (0)
#define SWRITE(b, i) do { *(u32x2*)((char*)V_lds + (b) * SHM_V + VSWZ(vd, vkc / 2)) = (u32x2){sr_[i].vs.x, sr_[i].vs.z};          \
    *(u32x2*)((char*)V_lds + (b) * SHM_V + VSWZ(vd, 32 + vkc / 2)) = (u32x2){sr_[i].vs.y, sr_[i].vs.w};                                      \
    *(u32x4*)((char*)K_lds + (b) * SHM_K + KSWZ8(kkey, kch)) = sr_[i].ks; } while (0)
#define SWAIT() asm volatile("s_waitcnt vmcnt(2)" ::: "memory")
#define RESC(a) do { if (__any((a) < 1.f)) { if (hi == 0) al_l[r32] = (a); asm volatile("s_waitcnt lgkmcnt(0)" ::: "memory"); \
    _Pragma("unroll") for (int d = 0; d < 4; ++d) _Pragma("unroll") for (int r = 0; r < 16; ++r) o[d][r] *= al_l[crow(r, hi)]; } } while (0)
    f32x16 pA0, pA1, pB0, pB1; float mnA, mnB, alA, alB; v8i32a P8;
    constexpr int SE = 0, SO = 1;
    SLOAD(SE, 0); asm volatile("s_waitcnt vmcnt(0)" ::: "memory"); SWRITE(0, SE); __syncthreads();
    qkt8(pA0, pA1, (const char*)K_lds, qr, r32, hi); if (BAND) mask_tile(pA0, pA1, dq0); partialSM(pA0, pA1, m_reg, mnA, alA, THR8);
    SLOAD(SO, KVBLK); if (2 < NT) SLOAD(SE, 2 * KVBLK);
    SWAIT(); SWRITE(1, SO); __syncthreads();
    for (int j = 1; j + 1 < NT; j += 2) {
        SBAR(); qkt8(pB0, pB1, (const char*)K_lds + SHM_K, qr, r32, hi);
        finishSM8(pA0, pA1, alA, l_reg, P8); SBAR();
        SLOAD(SO, (j + 2) * KVBLK); SBAR();
        pv8(o, (const char*)V_lds, P8, r32, hi); if (BAND) mask_tile(pB0, pB1, dq0 - 64 * j); partialSM(pB0, pB1, m_reg, mnB, alB, THR8);
        __syncthreads(); SWAIT(); SWRITE(0, SE);
        RESC(alB); __syncthreads();
        SBAR(); qkt8(pA0, pA1, (const char*)K_lds, qr, r32, hi);
        finishSM8(pB0, pB1, alB, l_reg, P8); SBAR();
        if (j + 3 < NT) SLOAD(SE, (j + 3) * KVBLK); SBAR();
        pv8(o, (const char*)V_lds + SHM_V, P8, r32, hi); if (BAND) mask_tile(pA0, pA1, dq0 - 64 * (j + 1)); partialSM(pA0, pA1, m_reg, mnA, alA, THR8);
        __syncthreads(); SWAIT(); SWRITE(1, SO);
        RESC(alA); __syncthreads();
    }
    SBAR(); qkt8(pB0, pB1, (const char*)K_lds + SHM_K, qr, r32, hi);
    finishSM8(pA0, pA1, alA, l_reg, P8); SBAR();
    pv8(o, (const char*)V_lds, P8, r32, hi); if (BAND) mask_tile(pB0, pB1, dq0 - 64 * (NT - 1)); partialSM(pB0, pB1, m_reg, mnB, alB, THR8);
    __syncthreads(); RESC(alB);
    finishSM8(pB0, pB1, alB, l_reg, P8); SBAR();
    pv8(o, (const char*)V_lds + SHM_V, P8, r32, hi);
    if (hi == 0) li_l[r32] = l_reg; asm volatile("s_waitcnt lgkmcnt(0)" ::: "memory");
    if (BAND) { if (hi == 0) lse_out[(wid * QBLK + r32) * lse_stride] = m_reg * SCALE + __logf(l_reg); }
    float rli[16];
#pragma unroll
    for (int r = 0; r < 16; ++r) rli[r] = __builtin_amdgcn_rcpf(li_l[crow(r, hi)]);
    int tide = tid; asm volatile("" : "+v"(tide));
    const int r32e = tide & 31, hie = (tide >> 5) & 1, wide = tide >> 6;
    if (BAND) { bf16_t* Ow = Ob + (size_t)(unsigned)((wide * QBLK + 4 * hie) * ldo + r32e);
#pragma unroll
        for (int r = 0; r < 16; ++r) { const int orow = (r & 3) + 8 * (r >> 2);
#pragma unroll
            for (int d0 = 0; d0 < 4; ++d0) Ow[orow * ldo + d0 * 32] = (bf16_t)f2bf(o[d0][r] * rli[r]); } }
    else {
        unsigned char* Ow = (unsigned char*)Ob + (size_t)(unsigned)((wide * QBLK + 4 * hie) * ldo + r32e);
#pragma unroll
        for (int r = 0; r < 16; ++r) { const int orow = (r & 3) + 8 * (r >> 2); const float sc = rli[r] * AB_SCALE;
#pragma unroll
            for (int d0 = 0; d0 < 4; d0 += 2) { const unsigned w = __builtin_amdgcn_cvt_pk_fp8_f32(__builtin_amdgcn_fmed3f(o[d0][r] * sc, -448.f, 448.f), __builtin_amdgcn_fmed3f(o[d0 + 1][r] * sc, -448.f, 448.f), 0u, false);
                Ow[orow * ldo + d0 * 32] = (unsigned char)(w & 0xffu); Ow[orow * ldo + d0 * 32 + 32] = (unsigned char)((w >> 8) & 0xffu); } } }
#undef SLOAD
#undef SWRITE
#undef SWAIT
#undef RESC
}

template <int LDQ, int LDO, int LSE_STRIDE>
__device__ __forceinline__ void band_unit(const bf16_t* __restrict__ Qb, const bf16_t* __restrict__ Kh, const bf16_t* __restrict__ Vh, bf16_t* __restrict__ Ob,
                                          int NT, int qoff, float* __restrict__ lse_out, char* lds, const int tid) {
    constexpr int ldq = LDQ, ldk = LDQ, ldo = LDO;
    const int wid = tid >> 6, lane = tid & 63, r32 = lane & 31, hi = lane >> 5;
    bf16_t* V_lds = (bf16_t*)lds; bf16_t* K_lds = (bf16_t*)(lds + 2 * SHM_V);
    float* ws = (float*)(lds + 2 * SHM_V + 2 * SHM_K) + wid * 64; float* li_l = ws; float* al_l = ws + 32;
    float m_reg = -1e30f, l_reg = 0; f32x16 o[4] = {}; bf16x8 qr[8];
    const bf16_t* Qw = Qb + (size_t)((wid * QBLK + r32) * ldq + hi * 8);
#pragma unroll
    for (int d0 = 0; d0 < 8; ++d0) qr[d0] = *reinterpret_cast<const bf16x8*>(Qw + d0 * 16);
    const int sr = tid >> 4, sc = (tid & 15) * 8, vst0 = v_st(sr, sc), vst1 = v_st(32 + sr, sc);
    const int vb0 = (int)(uintptr_t)V_lds + v_rd_base(lane);
    const int qw = qoff + wid * QBLK, dq0 = qw + r32 - 4 * hi;
    const unsigned lo0 = (unsigned)(sr * ldk + sc) * 2u, lo1 = lo0 + (unsigned)(32 * ldk * 2);
    bf16x8 vs0, vs1, ks0, ks1;
#define BLOAD(k0) do { const char* vb_ = (const char*)Vh + (size_t)(k0) * (ldk * 2); const char* kb_ = (const char*)Kh + (size_t)(k0) * (ldk * 2); \
    vs0 = *reinterpret_cast<const bf16x8*>(vb_ + lo0); vs1 = *reinterpret_cast<const bf16x8*>(vb_ + lo1); \
    ks0 = *reinterpret_cast<const bf16x8*>(kb_ + lo0); ks1 = *reinterpret_cast<const bf16x8*>(kb_ + lo1); } while (0)
#define BWRITE(b) do { *(bf16x8*)((char*)V_lds + (b) * SHM_V + vst0) = vs0; *(bf16x8*)((char*)V_lds + (b) * SHM_V + vst1) = vs1; const int kc = sc * 2; \
    *(bf16x8*)((char*)K_lds + (b) * SHM_K + KSWZ(sr, kc)) = ks0; *(bf16x8*)((char*)K_lds + (b) * SHM_K + KSWZ(32 + sr, kc)) = ks1; } while (0)
    BLOAD(0); BWRITE(0); __syncthreads();
    for (int j = 0; j < NT; ++j) {
        const int buf = j & 1;
        if (j + 1 < NT) BLOAD((j + 1) * KVBLK);
        if (64 * j <= qw + 95 && 64 * j + 127 >= qw) {
            f32x16 p0, p1; float mn, al; bf16x8 pa0, pa1, pa2, pa3;
            qkt(p0, p1, (bf16_t*)((char*)K_lds + buf * SHM_K), qr, r32, hi);
            mask_tile(p0, p1, dq0 - 64 * j);
            partialSM(p0, p1, m_reg, mn, al);
            if (__any(al < 1.f)) { if (hi == 0) al_l[r32] = al; asm volatile("s_waitcnt lgkmcnt(0)" ::: "memory");
#pragma unroll
                for (int d = 0; d < 4; ++d)
#pragma unroll
                    for (int r = 0; r < 16; ++r) o[d][r] *= al_l[crow(r, hi)]; }
            finishSM(p0, p1, al, l_reg, pa0, pa1, pa2, pa3); SBAR();
            pv_d0(o, vb0 + buf * (int)SHM_V, pa0, pa1, pa2, pa3);
        }
        if (j + 1 < NT) BWRITE(buf ^ 1);
        __syncthreads();
    }
    if (hi == 0) li_l[r32] = l_reg; asm volatile("s_waitcnt lgkmcnt(0)" ::: "memory");
    if (hi == 0) lse_out[(wid * QBLK + r32) * LSE_STRIDE] = m_reg * SCALE + __logf(l_reg);
    float rli[16];
#pragma unroll
    for (int r = 0; r < 16; ++r) rli[r] = __builtin_amdgcn_rcpf(li_l[crow(r, hi)]);
    bf16_t* Ow = Ob + (size_t)(wid * QBLK * ldo);
#pragma unroll
    for (int r = 0; r < 16; ++r) { const int orow = crow(r, hi);
#pragma unroll
        for (int d0 = 0; d0 < 4; ++d0) Ow[orow * ldo + d0 * 32 + r32] = (bf16_t)f2bf(o[d0][r] * rli[r]); }
    __syncthreads();
#undef BLOAD
#undef BWRITE
}
}

constexpr size_t MiB = 1u << 20;
constexpr size_t WS_CTL = 0, CTL_ZERO_BYTES = 1 * MiB;
constexpr size_t WS_MOD = 1 * MiB;
constexpr size_t WS_ROPEA = 1 * MiB + 512 * 1024;
constexpr size_t WS_ROPEB = 2 * MiB;
constexpr size_t WS_LSE = 2 * MiB + 512 * 1024;
constexpr size_t WS_TSEL = 3 * MiB;
constexpr size_t WS_TW = 3 * MiB + 256 * 1024;
constexpr size_t WS_CNTT = 3 * MiB + 512 * 1024;
constexpr size_t WS_TOK = 4 * MiB;
constexpr size_t WS_GATE = 6 * MiB;
constexpr size_t WS_WIN = 8 * MiB;
constexpr size_t WS_WAB = 54 * MiB;
constexpr size_t WS_WO = 64 * MiB;
constexpr size_t WS_W13 = 72 * MiB;
constexpr size_t WS_W2 = 332 * MiB;
constexpr size_t WS_H = 462 * MiB;
constexpr size_t WS_PROJ = 494 * MiB;
constexpr size_t WS_OA = 678 * MiB;
constexpr size_t WS_AB = 702 * MiB;
constexpr size_t WS_MERGED = 806 * MiB;
constexpr size_t WS_HID = 838 * MiB;
constexpr size_t WS_Y = 462 * MiB;
constexpr size_t WS_WRTH = 926 * MiB, WS_WRTL = 926 * MiB + 512 * 1024;
constexpr size_t WS_RBIAS = 1 * MiB + 128 * 1024;
constexpr size_t WS_H8 = 927 * MiB;
constexpr size_t WS_WG8 = WS_WIN + (size_t)GATE_OFF * DM;
constexpr size_t WS_VT8 = 943 * MiB;
constexpr size_t WS_K8 = 947 * MiB;
constexpr size_t WS_END = 951 * MiB;
static_assert(WS_Y + (size_t)MOE_ROWS * DM * 2 <= WS_HID && WS_HID + (size_t)MOE_ROWS * DE * 2 <= WS_WRTH, "ws map");
constexpr int CW_MODRDY = 32;
constexpr int CW_COUNT = 64;
constexpr int CW_CQ = 128;
constexpr int CW_DONE = 160;
constexpr int CW_BAR = 4096;

constexpr int RING_BYTES = 131072;
constexpr int MISC_OFF = RING_BYTES;
constexpr int LDS_BYTES = 147456;
constexpr int MI_TP = 16, MI_CNT = 96, MI_BC = 4;
constexpr int XS_OFF = MISC_OFF + 4096;

#define XB_TMO      128
#define XB_XCNT(j)  (256  + 64 * (j))
#define XB_XSUB(j)  (1280 + 64 * (j))
#define XB_XGEN(j)  (2304 + 64 * (j))
#define XB_TOP      3328
#define XB_TOPGEN   3392
#define XCD_BAR_WORDS 3456
#define XB_SPIN_CAP (1u << 18)
__device__ __forceinline__ unsigned xb_ld(unsigned* p)              { return __hip_atomic_load(p, __ATOMIC_RELAXED, __HIP_MEMORY_SCOPE_AGENT); }
__device__ __forceinline__ unsigned xb_add(unsigned* p, unsigned v) { return __hip_atomic_fetch_add(p, v, __ATOMIC_RELAXED, __HIP_MEMORY_SCOPE_AGENT); }
__device__ __forceinline__ unsigned xb_xcc_id() { return (unsigned)__builtin_amdgcn_s_getreg((3 << 11) | 20) & 0xFu; }
#define XB_SPIN(cond, bar) do { unsigned _sp = 0; while (cond) { __builtin_amdgcn_s_sleep(1); \
    if ((++_sp & 255u) == 0u) { if (xb_ld(&(bar)[XB_TMO])) break; if (_sp > XB_SPIN_CAP) { atomicAdd(&(bar)[XB_TMO], 1u); break; } } } } while (0)
struct XcdBarrier { unsigned* bar; unsigned x; volatile LAS unsigned* st; };
__device__ __forceinline__ XcdBarrier xcd_barrier_post(unsigned* bar, volatile LAS unsigned* st, const bool leader) {
    XcdBarrier b; b.bar = bar; b.x = xb_xcc_id(); b.st = st;
    if (leader) (void)xb_add(&bar[XB_XCNT(b.x)], 1u);
    return b;
}
__device__ __forceinline__ void xcd_barrier_complete(unsigned* bar, unsigned x, unsigned& nloc, unsigned& nx) {
    const unsigned G = gridDim.x * gridDim.y * gridDim.z;
    unsigned sum, cnt, mine, sp = 0u;
    for (;;) {
        sum = 0u; cnt = 0u; mine = 0u;
#pragma unroll
        for (unsigned j = 0; j < 16; ++j) { const unsigned c = xb_ld(&bar[XB_XCNT(j)]); sum += c; cnt += (c > 0u) ? 1u : 0u; mine = (j == x) ? c : mine; }
        if (sum == G) break;
        __builtin_amdgcn_s_sleep(1);
        if ((++sp & 255u) == 0u) { if (xb_ld(&bar[XB_TMO])) break; if (sp > XB_SPIN_CAP) { atomicAdd(&bar[XB_TMO], 1u); break; } }
    }
    nloc = mine > 0u ? mine : 1u; nx = cnt > 0u ? cnt : 1u;
}
__device__ __forceinline__ void xcd_barrier(const XcdBarrier& b, const bool leader) {
    asm volatile("s_waitcnt vmcnt(0)" ::: "memory");
    __syncthreads();
    if (leader) {
        unsigned* bar = b.bar;
        __builtin_amdgcn_s_waitcnt(0);
        unsigned nloc = b.st[0], nx = b.st[1];
        if (nloc == 0u) { xcd_barrier_complete(bar, b.x, nloc, nx); b.st[0] = nloc; b.st[1] = nx; }
        const unsigned old = xb_add(&bar[XB_XSUB(b.x)], 1u);
        const unsigned gen = old / nloc;
        if (old + 1u == (gen + 1u) * nloc) {
            __builtin_amdgcn_fence(__ATOMIC_RELEASE, "agent");
            asm volatile("s_waitcnt vmcnt(0)" ::: "memory");
            const unsigned og = xb_add(&bar[XB_TOP], 1u);
            const unsigned tg = og / nx;
            if (og + 1u == (tg + 1u) * nx) xb_add(&bar[XB_TOPGEN], 1u);
            else XB_SPIN(xb_ld(&bar[XB_TOPGEN]) == tg, bar);
            __builtin_amdgcn_fence(__ATOMIC_ACQUIRE, "agent");
            xb_add(&bar[XB_XGEN(b.x)], 1u);
            asm volatile("s_waitcnt vmcnt(0)" ::: "memory");
        } else {
            XB_SPIN(xb_ld(&bar[XB_XGEN(b.x)]) == gen, bar);
            __builtin_amdgcn_fence(__ATOMIC_ACQUIRE, "agent");
            asm volatile("s_waitcnt vmcnt(0)" ::: "memory");
        }
    }
    __syncthreads();
}

constexpr int NWAVES = 8, NTHREADS = 512;
struct Args {
    const float *x, *c, *w_ada, *b_ada, *g_attn, *w_in, *b_gate, *q_norm_g, *k_norm_g, *w_a_up, *w_b_up, *w_out, *g_ffn, *w_router, *e_bias, *w1, *w3, *w2, *ws1, *ws3, *ws2, *g_final;
    float* out; unsigned char* ws; int ph_lo, ph_hi;
};
#define LDS_WAIT() asm volatile("s_waitcnt lgkmcnt(0)" ::: "memory")
__device__ __forceinline__ float wave_sum(float v) {
#define WS_SWZ(k) v += __uint_as_float((unsigned)__builtin_amdgcn_ds_swizzle((int)__float_as_uint(v), ((k) << 10) | 0x1f))
    WS_SWZ(1); WS_SWZ(2); WS_SWZ(4); WS_SWZ(8); WS_SWZ(16);
#undef WS_SWZ
    auto rr = __builtin_amdgcn_permlane32_swap(__float_as_uint(v), __float_as_uint(v), false, false);
    return __uint_as_float(rr[0]) + __uint_as_float(rr[1]);
}
template <int CTRL> __device__ __forceinline__ int dpp_i(int x) { return __builtin_amdgcn_update_dpp(0, x, CTRL, 0xf, 0xf, true); }
__device__ __forceinline__ float grp8_max(float x) {
    x = fmaxf(x, __builtin_bit_cast(float, dpp_i<0xB1>(__builtin_bit_cast(int, x)))); x = fmaxf(x, __builtin_bit_cast(float, dpp_i<0x4E>(__builtin_bit_cast(int, x))));
    return fmaxf(x, __builtin_bit_cast(float, dpp_i<0x141>(__builtin_bit_cast(int, x)))); }
__device__ __forceinline__ int grp8_min(int x) { x = min(x, dpp_i<0xB1>(x)); x = min(x, dpp_i<0x4E>(x)); return min(x, dpp_i<0x141>(x)); }
__device__ __forceinline__ float lane_bcast(float x, int l) { return __builtin_bit_cast(float, __builtin_amdgcn_readlane(__builtin_bit_cast(int, x), l)); }
__device__ const float ROPE_INV_A[16] = {1.000000000e+00f, 4.403665960e-01f, 1.939227432e-01f, 8.539710194e-02f, 3.760603070e-02f, 1.656044088e-02f, 7.292664610e-03f, 3.211446106e-03f,
    1.414213562e-03f, 6.227724371e-04f, 2.742481884e-04f, 1.207697351e-04f, 5.318295734e-05f, 2.341999971e-05f, 1.031338525e-05f, 4.541670478e-06f};
__device__ const float ROPE_INV_B[32] = {1.000000000e+00f, 7.498942018e-01f, 5.623413324e-01f, 4.216965139e-01f, 3.162277639e-01f, 2.371373773e-01f, 1.778279394e-01f, 1.333521456e-01f,
    1.000000015e-01f, 7.498942316e-02f, 5.623413250e-02f, 4.216964915e-02f, 3.162277490e-02f, 2.371373773e-02f, 1.778279431e-02f, 1.333521400e-02f, 9.999999776e-03f, 7.498942316e-03f,
    5.623413250e-03f, 4.216964822e-03f, 3.162277630e-03f, 2.371373819e-03f, 1.778279431e-03f, 1.333521446e-03f, 1.000000047e-03f, 7.498941850e-04f, 5.623413017e-04f, 4.216965172e-04f,
    3.162277571e-04f, 2.371373703e-04f, 1.778279402e-04f, 1.333521504e-04f};
__device__ __forceinline__ void cos_sin_reduced(float ang, float& c, float& s) {
    const float n = rintf(ang * 0.15915494309189535f);
    float r = fmaf(-n, 6.28125f, ang); r = fmaf(-n, 1.935307169333e-03f, r); r = fmaf(-n, 1.025313167702e-11f, r);
    c = cosf(r); s = sinf(r);
}

__device__ __forceinline__ int win_dest_row(int n) {
    if (n < A_COLS) { const int w = n % 1536, d = n & 127; if (w >= 1024 || d >= 32) return n; return (n & ~31) + 2 * (d & 15) + (d >> 4); }
    if (n < BV_OFF) { const int dd = n & 63; return (n & ~63) + 2 * (dd & 31) + (dd >> 5); }
    return n;
}
template <bool ROWMAP>
__device__ __forceinline__ void copy_item_bf16(const float* W, int ldn, int K, bf16_t* WT, int drow0, int k0, int n0, int lane) {
    const int r = lane >> 3, c4 = lane & 7;
    const float* p = W + (size_t)(k0 + 8 * r) * ldn + n0 + 4 * c4;
    f32x4 v[8];
#pragma unroll
    for (int i = 0; i < 8; ++i) v[i] = __builtin_nontemporal_load((const f32x4*)(p + (size_t)i * ldn));
#pragma unroll
    for (int j = 0; j < 4; ++j) {
        u32x4 o; o.x = cvt_pk_bf16(v[0][j], v[1][j]); o.y = cvt_pk_bf16(v[2][j], v[3][j]); o.z = cvt_pk_bf16(v[4][j], v[5][j]); o.w = cvt_pk_bf16(v[6][j], v[7][j]);
        const int row = ROWMAP ? win_dest_row(n0 + 4 * c4 + j) : drow0 + 4 * c4 + j;
        *(u32x4*)(WT + (size_t)row * K + k0 + 8 * r) = o; }
}
template <bool ROWMAP = false>
__device__ __forceinline__ void copy_item_fp8(const float* W, int ldn, int K, unsigned char* WT, int drow0, int k0, int n0, int lane, float sc) {
    const int r = lane >> 3, c4 = lane & 7;
    const float* p = W + (size_t)(k0 + 16 * r) * ldn + n0 + 4 * c4;
    f32x4 v[16];
#pragma unroll
    for (int i = 0; i < 16; ++i) v[i] = __builtin_nontemporal_load((const f32x4*)(p + (size_t)i * ldn));
#pragma unroll
    for (int j = 0; j < 4; ++j) {
        unsigned o[4];
#pragma unroll
        for (int q = 0; q < 4; ++q) { unsigned w = 0; w = __builtin_amdgcn_cvt_pk_fp8_f32(v[4 * q][j] * sc, v[4 * q + 1][j] * sc, w, false); w = __builtin_amdgcn_cvt_pk_fp8_f32(v[4 * q + 2][j] * sc, v[4 * q + 3][j] * sc, w, true); o[q] = w; }
        const int row = ROWMAP ? win_dest_row(n0 + 4 * c4 + j) : drow0 + 4 * c4 + j;
        __builtin_nontemporal_store((u32x4){o[0], o[1], o[2], o[3]}, (u32x4*)(WT + (size_t)row * K + k0 + 16 * r)); }
}

#define CQ_LOAD(v, off) _Pragma("unroll") for (int i = 0; i < 16; ++i) v[i] = __builtin_nontemporal_load((const f32x4*)(p + (size_t)i * ldn + (off)))
#define CQ_CVT(v, rowoff) _Pragma("unroll") for (int j = 0; j < 4; ++j) { unsigned o[4]; \
        _Pragma("unroll") for (int q = 0; q < 4; ++q) { unsigned w = 0; w = __builtin_amdgcn_cvt_pk_fp8_f32(v[4 * q][j] * sc, v[4 * q + 1][j] * sc, w, false); w = __builtin_amdgcn_cvt_pk_fp8_f32(v[4 * q + 2][j] * sc, v[4 * q + 3][j] * sc, w, true); o[q] = w; } \
        __builtin_nontemporal_store((u32x4){o[0], o[1], o[2], o[3]}, (u32x4*)(d + (size_t)((rowoff) + j) * K)); }

struct MoeSched1 {
    static constexpr bool GATHER = true;
    const char* A; const char* Bt; const unsigned* tok_of; LAS const int* tp; LAS const int* cnt; int G, c, lane;
    __device__ __forceinline__ bool next(int i, pg8::Unit& u) const {
        int L = i * G + c; if ((G & 255) == 0) { const int x = c & 7, j = (c & 255) >> 3; L = (i * (G >> 8) + (c >> 8)) * 256 + ((8 * x + (j >> 2)) << 2) + (j & 3); }
        const int total = tp[NEX] * 4; if (L >= total) return false;
        const int gm = L >> 2;
        const int e = __builtin_popcountll(__ballot(tp[lane + 1] <= gm));
        u.pm = gm; u.pn = L & 3; u.e = __builtin_amdgcn_readfirstlane(e); u.aux = (gm - tp[u.e]) * 256; return true;
    }
    __device__ __forceinline__ const char* a_tile(const pg8::Unit&) const { return A; }
    __device__ __forceinline__ const char* b_tile(const pg8::Unit& u) const { return Bt + (size_t)u.e * (1024 * DM) + (size_t)u.pn * (256 * DM); }
    __device__ __forceinline__ void a_voff(const pg8::Unit& u, const int (&R)[2], const int (&C)[2], unsigned (&v)[2][2]) const {
        const int ce = cnt[u.e];
#pragma unroll
        for (int h = 0; h < 2; ++h)
#pragma unroll
            for (int i = 0; i < 2; ++i) { const int slot = u.aux + 128 * h + R[i]; unsigned tok = (unsigned)slot;
                if (u.e < NE) tok = slot < ce ? tok_of[(size_t)u.e * ECAP + slot] : 0u;
                v[h][i] = tok * (unsigned)DM + (unsigned)C[i] * 2u; }
    }
};
struct MoeSched2 {
    static constexpr bool GATHER = false;
    const char* A; const char* Bt; LAS const int* tp; int G, c, lane;
    __device__ __forceinline__ bool next(int i, pg8::Unit& u) const {
        int L = i * G + c; if ((G & 255) == 0) { const int x = c & 7, j = (c & 255) >> 3; L = (i * (G >> 8) + (c >> 8)) * 256 + ((4 * x + (j >> 3)) << 3) + (j & 7); }
        const int total = tp[NEX] * 8; if (L >= total) return false;
        const int gm = L >> 3;
        const int e = __builtin_popcountll(__ballot(tp[lane + 1] <= gm));
        u.pm = gm; u.pn = L & 7; u.e = __builtin_amdgcn_readfirstlane(e); u.aux = 0; return true;
    }
    __device__ __forceinline__ const char* a_tile(const pg8::Unit& u) const { return A + (size_t)u.pm * (256 * DE); }
    __device__ __forceinline__ const char* b_tile(const pg8::Unit& u) const { return Bt + (size_t)u.e * (DM * DE) + (size_t)u.pn * (256 * DE); }
    __device__ __forceinline__ void a_voff(const pg8::Unit&, const int (&R)[2], const int (&C)[2], unsigned (&v)[2][2]) const {
#pragma unroll
        for (int h = 0; h < 2; ++h)
#pragma unroll
            for (int i = 0; i < 2; ++i) v[h][i] = (unsigned)((R[i] + 128 * h) * DE + C[i] * 2);
    }
};

constexpr int NPHASE = 13;
typedef const __attribute__((address_space(4))) Args ArgsK;
__device__ __forceinline__ ArgsK* args_ptr() { ArgsK* p = (ArgsK*)__builtin_amdgcn_kernarg_segment_ptr(); asm volatile("" : "+s"(p)); return p; }
#define PHASE_ARGS ArgsK& a = *args_ptr(); unsigned char* const ws = a.ws; (void)ws; int tid_ = threadIdx.x; asm volatile("" : "+v"(tid_)); __builtin_assume((unsigned)tid_ < 512u); const int tid = tid_, lane = tid & 63; (void)tid; (void)lane;
#define WSP(T, off) ((T*)(ws + (off)))
constexpr int NQ13 = 2 * NEX * 256, NQ2 = NEX * 256, NCH = (NQ13 + NQ2) / 32;
__device__ __forceinline__ void bg_fill(ArgsK& a, unsigned char* ws, volatile LAS unsigned* MISC, int slot, int G, int wave, int tid, int lane, int maxc = 1 << 30) {
    unsigned* cq = (unsigned*)(ws + WS_CTL) + CW_CQ; unsigned* dn = (unsigned*)(ws + WS_CTL) + CW_DONE + 32 * (slot < 0 ? 0 : slot);
    __syncthreads();
    if (tid == 0) { unsigned c0 = (unsigned)NCH; bool last = false;
        if (slot >= 0) last = __hip_atomic_fetch_add(dn, 1u, __ATOMIC_RELAXED, __HIP_MEMORY_SCOPE_AGENT) + 1u >= (unsigned)G;
        if (!last) c0 = __hip_atomic_fetch_add(cq, 1u, __ATOMIC_RELAXED, __HIP_MEMORY_SCOPE_AGENT);
        MISC[MI_BC] = c0; }
    __syncthreads();
    int zv = 0; asm volatile("" : "+v"(zv));
    int par = 0, left = maxc; unsigned c = (unsigned)__builtin_amdgcn_readfirstlane((int)MISC[MI_BC]);
    while (c < (unsigned)NCH) {
        --left;
        const int q = 32 * (int)c + 4 * wave;
        const float* src; unsigned char* dst; int ldn, K, drow, k0, n0; float sc;
        if (q < NQ13) { const int which = q / (NEX * 256), r = q - which * (NEX * 256), e = r >> 8, rr = r & 255; k0 = 128 * (rr >> 4); n0 = 32 * (rr & 15);
            src = (e < NE) ? ((which ? a.w3 : a.w1) + (size_t)e * DM * DE) : (which ? a.ws3 : a.ws1); ldn = DE; K = DM; dst = ws + WS_W13 + (size_t)e * 1024 * DM; drow = (n0 >> 7) * 256 + which * 128 + (n0 & 127); sc = W13_SCALE; }
        else { const int r = q - NQ13, e = r >> 8, rr = r & 255; k0 = 128 * (rr >> 6); n0 = 32 * (rr & 63);
            src = (e < NE) ? (a.w2 + (size_t)e * DE * DM) : a.ws2; ldn = DM; K = DE; dst = ws + WS_W2 + (size_t)e * DM * DE; drow = n0; sc = W2_SCALE; }
        const int r16 = lane >> 3, c4 = lane & 7;
        const float* p = src + (size_t)(k0 + 16 * r16) * ldn + n0 + 4 * c4; unsigned char* d = dst + (size_t)(drow + 4 * c4) * K + k0 + 16 * r16;
        unsigned dv = 0u, nx = (unsigned)NCH;
        if (tid == 0 && slot >= 0) dv = __hip_atomic_load(dn, __ATOMIC_RELAXED, __HIP_MEMORY_SCOPE_AGENT);
        f32x4 va[16], vb[16];
        CQ_LOAD(va, 0); CQ_LOAD(vb, 32);
        CQ_CVT(va, 0);
        if (tid == 0 && left > 0 && !(slot >= 0 && dv >= (unsigned)G)) nx = __hip_atomic_fetch_add(cq + zv, 1u, __ATOMIC_RELAXED, __HIP_MEMORY_SCOPE_AGENT);
        CQ_LOAD(va, 64); CQ_CVT(vb, 32); CQ_LOAD(vb, 96); CQ_CVT(va, 64); CQ_CVT(vb, 96);
        if (tid == 0) MISC[MI_BC + (par ^ 1)] = nx;
        asm volatile("s_waitcnt lgkmcnt(0)" ::: "memory"); __builtin_amdgcn_s_barrier();
        par ^= 1; c = (unsigned)__builtin_amdgcn_readfirstlane((int)MISC[MI_BC + par]);
    }
}

__global__ void __launch_bounds__(NTHREADS, 2) fwd_kernel(Args a_in) {
    extern __shared__ __attribute__((aligned(16))) unsigned char lds_raw[];
    LAS unsigned char* lds = (LAS unsigned char*)lds_raw;
    volatile LAS unsigned* MISC = (volatile LAS unsigned*)(lds + MISC_OFF);
    const int wave = __builtin_amdgcn_readfirstlane((int)(threadIdx.x >> 6));
    const int G = gridDim.x, bx = blockIdx.x;
    const int gw = bx * NWAVES + wave, NGW = G * NWAVES;
#define TID_LANE const int tid = threadIdx.x, lane = tid & 63; (void)tid; (void)lane;
    unsigned* ctl = (unsigned*)(a_in.ws + WS_CTL);
    { TID_LANE for (int u = tid; u < (LDS_BYTES - MISC_OFF) / 4; u += NTHREADS) MISC[u] = 0u; }
    __syncthreads();
    XcdBarrier bar; bar.bar = ctl + CW_BAR; bar.x = 0; bar.st = nullptr;
    if (MK_N_LAUNCHES == 1) bar = xcd_barrier_post(ctl + CW_BAR, MISC + 0, wave == 0 && lane_id() == 0);
    const int lo = a_in.ph_lo, hi = a_in.ph_hi;
#ifdef PHASE_MASK
#define IN(k) (((PHASE_MASK >> (k)) & 1) && lo <= (k) && (k) < hi)
#elif defined(ONLY_PHASE)
#define IN(k) ((k) == ONLY_PHASE && lo <= (k) && (k) < hi)
#else
#define IN(k) (lo <= (k) && (k) < hi)
#endif
#define SEAM(k) do { if (IN(k) && IN((k) + 1)) xcd_barrier(bar, wave == 0 && lane_id() == 0); } while (0)

    if (IN(0)) {
        PHASE_ARGS float* MOD = WSP(float, WS_MOD); float* ROPEA = WSP(float, WS_ROPEA); float* ROPEB = WSP(float, WS_ROPEB);
        unsigned char* WIN8 = WSP(unsigned char, WS_WIN); unsigned char* WAB8 = WSP(unsigned char, WS_WAB); unsigned char* WO8 = WSP(unsigned char, WS_WO);
        {
            LAS float* cs = (LAS float*)lds;
            LAS float* red = (LAS float*)(lds + 16384);
            for (int nb = bx; nb < (6 * DM) / 48; nb += G) {
                for (int i = tid; i < 2 * DM; i += NTHREADS) { const float v = a.c[i]; cs[i] = v / (1.0f + __expf(-v)); }
                __syncthreads();
                const int c4 = tid % 12, kk = tid / 12, n0 = nb * 48 + 4 * c4;
                if (kk < 42) {
                    f32x4 acc0 = {0.f, 0.f, 0.f, 0.f}, acc1 = {0.f, 0.f, 0.f, 0.f};
#pragma unroll 8
                    for (int k = kk; k < DM; k += 42) { const f32x4 w = __builtin_nontemporal_load((const f32x4*)(a.w_ada + (size_t)k * (6 * DM) + n0)); acc0 += w * cs[k]; acc1 += w * cs[DM + k]; }
                    *(LAS f32x4*)(red + (kk * 12 + c4) * 8) = acc0; *(LAS f32x4*)(red + (kk * 12 + c4) * 8 + 4) = acc1;
                }
                __syncthreads();
                if (tid < 96) { const int b = tid / 48, cc = tid % 48; float s = 0.f;
                    for (int k2 = 0; k2 < 42; ++k2) s += red[(k2 * 12 + (cc >> 2)) * 8 + b * 4 + (cc & 3)];
                    __hip_atomic_store(MOD + b * (6 * DM) + nb * 48 + cc, s + a.b_ada[nb * 48 + cc], __ATOMIC_RELAXED, __HIP_MEMORY_SCOPE_AGENT); }
                asm volatile("s_waitcnt vmcnt(0)" ::: "memory");
                __syncthreads();
                if (tid == 0) __hip_atomic_fetch_add(WSP(unsigned, WS_CTL) + CW_MODRDY, 1u, __ATOMIC_RELAXED, __HIP_MEMORY_SCOPE_AGENT);
            }
        }
        for (int i = bx * NTHREADS + tid; i < SEQ * 16; i += G * NTHREADS) { const int t = i >> 4, f = i & 15; float c, s; cos_sin_reduced((float)t * ROPE_INV_A[f], c, s); ROPEA[2 * i] = c; ROPEA[2 * i + 1] = s; }
        for (int i = bx * NTHREADS + tid; i < 64 * 32; i += G * NTHREADS) { const int p = i >> 5, f = i & 31; float c, s; cos_sin_reduced((float)p * ROPE_INV_B[f], c, s); ROPEB[2 * i] = c; ROPEB[2 * i + 1] = s; }
        {
            constexpr int I_IN = (DM / 128) * (GATE_OFF / 32), I_G = (DM / 128) * ((IN_COLS - GATE_OFF) / 32), I_A = (512 / 128) * (DM / 32), I_SQ = (DM / 128) * (DM / 32), I_O8 = (DM / 128) * (DM / 32);
            constexpr int NITEMS = I_IN + I_G + I_A + I_SQ + I_O8;
            for (int it = gw; it < NITEMS; it += NGW) {
                int r = it;
                if (r < I_IN) { const int nblk = GATE_OFF / 32, kb = r / nblk, nb = r % nblk; copy_item_fp8<true>(a.w_in, IN_COLS, DM, WIN8, 0, 128 * kb, 32 * nb, lane, WG_SCALE); continue; } r -= I_IN;
                if (r < I_G) { const int nblk = (IN_COLS - GATE_OFF) / 32, kb = r / nblk, nb = r % nblk; copy_item_fp8(a.w_in, IN_COLS, DM, WSP(unsigned char, WS_WG8), 32 * nb, 128 * kb, GATE_OFF + 32 * nb, lane, WG_SCALE); continue; } r -= I_G;
                if (r < I_A) { const int nblk = DM / 32, kb = r / nblk, nb = r % nblk; copy_item_fp8(a.w_a_up, DM, KAB, WAB8, 32 * nb, 128 * kb, 32 * nb, lane, WAB_SCALE); continue; } r -= I_A;
                if (r < I_SQ) { const int nblk = DM / 32, kb = r / nblk, nb = r % nblk; copy_item_fp8(a.w_b_up, DM, KAB, WAB8 + 512, 32 * nb, 128 * kb, 32 * nb, lane, WAB_SCALE); continue; } r -= I_SQ;
                { const int nblk = DM / 32, kb = r / nblk, nb = r % nblk; copy_item_fp8(a.w_out, DM, DM, WO8, 32 * nb, 128 * kb, 32 * nb, lane, WO_SCALE); }
            }
        }
        { bf16_t* H = WSP(bf16_t, WS_H);
          if (tid < 64) { unsigned sp = 0; while ((unsigned)__builtin_amdgcn_readfirstlane((int)__hip_atomic_load(WSP(unsigned, WS_CTL) + CW_MODRDY, __ATOMIC_RELAXED, __HIP_MEMORY_SCOPE_AGENT)) < (unsigned)((6 * DM) / 48)) { __builtin_amdgcn_s_sleep(2); if (++sp > (1u << 22)) break; }
              __builtin_amdgcn_fence(__ATOMIC_ACQUIRE, "agent"); asm volatile("s_waitcnt vmcnt(0)" ::: "memory"); }
          __syncthreads();
          { bf16_t* WRTH = WSP(bf16_t, WS_WRTH); bf16_t* WRTL = WSP(bf16_t, WS_WRTL); float* RB = WSP(float, WS_RBIAS);
            for (int i = bx * NTHREADS + tid; i < 2 * DM * NE; i += G * NTHREADS) { const int k = i % DM, e = (i / DM) % NE, b = i / (DM * NE);
                const float w = a.w_router[k * NE + e] * (a.g_ffn[k] * (MOD[b * (6 * DM) + 4 * DM + k] + 1.0f)); const unsigned hb = f2bf(w); const float hf = __uint_as_float(hb << 16);
                WRTH[i] = (bf16_t)hb; WRTL[i] = (bf16_t)f2bf(w - hf); }
            for (int j = gw; j < 2 * NE; j += NGW) { const int b = j >> 6, e = j & 63; float sb = 0.f;
#pragma unroll 8
                for (int k = lane; k < DM; k += 64) sb += MOD[b * (6 * DM) + 3 * DM + k] * a.w_router[k * NE + e];
                sb = wave_sum(sb); if (lane == 0) RB[j] = sb; } }
        for (int m = gw; m < MTOK; m += NGW) {
            const int b = m / SEQ; const float* mod = MOD + b * (6 * DM);
            const f32x4* xr = (const f32x4*)(a.x + (size_t)m * DM) + lane;
            f32x4 v[8]; float s = 0.f;
#pragma unroll
            for (int j = 0; j < 8; ++j) { v[j] = xr[64 * j]; s += (v[j].x * v[j].x + v[j].y * v[j].y) + (v[j].z * v[j].z + v[j].w * v[j].w); }
            const float rstd = 1.0f / sqrtf(wave_sum(s) * (1.f / DM) + EPS);
            unsigned* o4 = (unsigned*)(WSP(unsigned char, WS_H8) + (size_t)m * DM) + lane;
#pragma unroll
            for (int j = 0; j < 8; ++j) { const int col = 4 * lane + 256 * j;
                const f32x4 g = *(const f32x4*)(a.g_attn + col), sh = *(const f32x4*)(mod + col), sc = *(const f32x4*)(mod + DM + col);
                const f32x4 y = v[j] * rstd * g * (sc + 1.0f) + sh;
                unsigned w8 = 0; w8 = __builtin_amdgcn_cvt_pk_fp8_f32(y.x, y.y, w8, false); w8 = __builtin_amdgcn_cvt_pk_fp8_f32(y.z, y.w, w8, true); o4[64 * j] = w8; }
        }
        }
    }
    SEAM(1);
    if (IN(2)) {
        PHASE_ARGS const unsigned char* H8 = WSP(unsigned char, WS_H8); const unsigned char* WIN8 = WSP(unsigned char, WS_WIN); bf16_t* PROJ = WSP(bf16_t, WS_PROJ); const float* ROPEA = WSP(float, WS_ROPEA); const float* ROPEB = WSP(float, WS_ROPEB);
        pg8::DenseSched8 S; S.A = (const char*)H8; S.Bt = (const char*)WIN8; S.K = DM; S.o.init(MTOK, IN_COLS, G, bx);
        pg8::EpiProj E{PROJ, a.b_gate, ROPEA, ROPEB, a.q_norm_g, a.k_norm_g, (LAS float*)(lds + XS_OFF), WSP(unsigned char, WS_VT8), WSP(unsigned char, WS_K8)};
        pg8::gemm_phase<pg8::EpiProj, pg8::DenseSched8, true, true>(lds, DM, S, E, tid);
        bg_fill(a, ws, MISC, 0, G, wave, tid, lane);
    }
    SEAM(3);
    if (IN(4)) {
        PHASE_ARGS const bf16_t* PROJ = WSP(bf16_t, WS_PROJ); bf16_t* OA = WSP(bf16_t, WS_OA); unsigned char* AB8 = WSP(unsigned char, WS_AB); float* LSE = WSP(float, WS_LSE);
        char* alds = (char*)lds_raw;
#ifndef NO_ATT_B
        int it = 0;
#pragma unroll 1
        for (int u = bx; u < 512; u += G, ++it) {
            if (FORCE_NF > 0 && it == (bx & 3)) bg_fill(a, ws, MISC, -1, G, wave, tid, lane, FORCE_NF);
            const int b = u >> 8, c = u & 255, xcd = c & 7, j = c >> 3, kvh = xcd >> 1, local = (xcd & 1) * 32 + j, hq = kvh * 4 + (local >> 4), qb = local & 15;
            const bf16_t* base = PROJ + (size_t)(b * SEQ) * IN_COLS;
            att::attn_unit<false, IN_COLS, KAB, 0>(base + (size_t)(qb * 256) * IN_COLS + BQ_OFF + hq * HD, (const bf16_t*)(WSP(unsigned char, WS_K8) + (size_t)((b * 4 + kvh) * SEQ) * HD), (const bf16_t*)(WSP(unsigned char, WS_VT8) + (size_t)((b * 4 + kvh) * HD) * SEQ),
                                  (bf16_t*)(AB8 + (size_t)(b * SEQ + qb * 256) * KAB + 512 + hq * HD), SEQ / 64, 0, nullptr, alds, tid);
        }
#endif
    }
    if (IN(4)) {
        PHASE_ARGS const bf16_t* PROJ = WSP(bf16_t, WS_PROJ); bf16_t* OA = WSP(bf16_t, WS_OA); float* LSE = WSP(float, WS_LSE);
        char* alds = (char*)lds_raw;
#ifndef NO_ATT_A
#pragma unroll 1
        for (int st = 2; st < 4; ++st) {
        if (FORCE_NF > 0 && st == (bx & 3)) bg_fill(a, ws, MISC, -1, G, wave, tid, lane, FORCE_NF);
        if (st == 2)
#pragma unroll 1
        for (int u = bx; u < 384; u += G) {
            const int sub = u & 15, h = (u >> 4) & 3, g = (u >> 6) % 3, b = u / 192;
            const int dil = (g == 0) ? 1 : (g == 1 ? 4 : 16), L = SEQ / dil, nqb = L / 256;
            const int res = sub / nqb, qb = sub % nqb, q0 = qb * 256;
            const int NT = (L / 64) < 6 ? (L / 64) : 6;
            int klo = q0 - 64; if (klo < 0) klo = 0; if (klo > L - 64 * NT) klo = L - 64 * NT;
            const bf16_t* base = PROJ + (size_t)(b * SEQ + res) * IN_COLS + g * 1536 + h * HD;
            const long ld = (long)dil * IN_COLS;
            bf16_t* op = OA + (size_t)g * MTOK * 512 + (size_t)(b * SEQ + res + q0 * dil) * 512 + h * HD;
            float* lp = LSE + (size_t)g * MTOK * 4 + (size_t)(b * SEQ + res + q0 * dil) * 4 + h;
            if (g == 0)      att::band_unit<IN_COLS, 512, 4>(base + (size_t)q0 * ld, base + 512 + (size_t)klo * ld, base + 1024 + (size_t)klo * ld, op, NT, q0 - klo, lp, alds, tid);
            else if (g == 1) att::band_unit<4 * IN_COLS, 4 * 512, 16>(base + (size_t)q0 * ld, base + 512 + (size_t)klo * ld, base + 1024 + (size_t)klo * ld, op, NT, q0 - klo, lp, alds, tid);
            else             att::band_unit<16 * IN_COLS, 16 * 512, 64>(base + (size_t)q0 * ld, base + 512 + (size_t)klo * ld, base + 1024 + (size_t)klo * ld, op, NT, q0 - klo, lp, alds, tid);
        }
        }
#endif
        bg_fill(a, ws, MISC, 1, G, wave, tid, lane);
    }
    SEAM(4);
    if (IN(5)) {
        PHASE_ARGS const bf16_t* OA = WSP(bf16_t, WS_OA); const float* LSE = WSP(float, WS_LSE); unsigned char* AB8 = WSP(unsigned char, WS_AB);
        for (int m = gw; m < MTOK; m += NGW) {
            const int h = lane >> 4;
            const float l0 = LSE[(size_t)m * 4 + h], l1 = LSE[(size_t)(MTOK + m) * 4 + h], l2 = LSE[(size_t)(2 * MTOK + m) * 4 + h];
            const float mx = fmaxf(l0, fmaxf(l1, l2)); const float e0 = __expf(l0 - mx), e1 = __expf(l1 - mx), e2 = __expf(l2 - mx); const float inv = 1.0f / (e0 + e1 + e2);
            f32x4 a0, a1, b0, b1, c0, c1;
            unpack8(*(const u32x4*)(OA + (size_t)m * 512 + 8 * lane), a0, a1);
            unpack8(*(const u32x4*)(OA + (size_t)(MTOK + m) * 512 + 8 * lane), b0, b1);
            unpack8(*(const u32x4*)(OA + (size_t)(2 * MTOK + m) * 512 + 8 * lane), c0, c1);
            const float w0 = e0 * inv, w1 = e1 * inv, w2 = e2 * inv;
            f32x4 v0 = (a0 * w0 + b0 * w1 + c0 * w2) * AB_SCALE, v1 = (a1 * w0 + b1 * w1 + c1 * w2) * AB_SCALE; unsigned lo = 0, hi = 0;
#pragma unroll
            for (int j = 0; j < 4; ++j) { v0[j] = __builtin_amdgcn_fmed3f(v0[j], -448.f, 448.f); v1[j] = __builtin_amdgcn_fmed3f(v1[j], -448.f, 448.f); }
            lo = __builtin_amdgcn_cvt_pk_fp8_f32(v0[0], v0[1], lo, false); lo = __builtin_amdgcn_cvt_pk_fp8_f32(v0[2], v0[3], lo, true);
            hi = __builtin_amdgcn_cvt_pk_fp8_f32(v1[0], v1[1], hi, false); hi = __builtin_amdgcn_cvt_pk_fp8_f32(v1[2], v1[3], hi, true);
            *(u32x2*)(AB8 + (size_t)m * KAB + 8 * lane) = (u32x2){lo, hi};
        }
    }
    SEAM(5);
    if (IN(6)) {
        PHASE_ARGS const unsigned char* AB8 = WSP(unsigned char, WS_AB); const unsigned char* WAB8 = WSP(unsigned char, WS_WAB); const bf16_t* PROJ = WSP(bf16_t, WS_PROJ); unsigned char* MERGED = WSP(unsigned char, WS_MERGED);
        pg8::DenseSched8 S; S.A = (const char*)AB8; S.Bt = (const char*)WAB8; S.K = KAB; S.o.init(MTOK, DM, G, bx);
        pg8::EpiMerged2 E{MERGED, PROJ};
        pg8::gemm_phase<pg8::EpiMerged2, pg8::DenseSched8, true, true>(lds, KAB, S, E, tid);
    }
    SEAM(6);
    if (IN(7)) {
        PHASE_ARGS const unsigned char* MERGED = WSP(unsigned char, WS_MERGED); const unsigned char* WO8 = WSP(unsigned char, WS_WO); const float* MOD = WSP(float, WS_MOD); float* X1 = a.out;
        pg8::DenseSched8 S; S.A = (const char*)MERGED; S.Bt = (const char*)WO8; S.K = DM; S.o.init(MTOK, DM, G, bx);
        pg8::EpiX1 E{X1, a.x, MOD};
        pg8::gemm_phase<pg8::EpiX1, pg8::DenseSched8, true, true>(lds, DM, S, E, tid);
    }
    SEAM(7);
    if (IN(8)) {
        PHASE_ARGS const float* MOD = WSP(float, WS_MOD); const float* X1 = a.out; unsigned char* H8 = WSP(unsigned char, WS_H);
        unsigned* TSEL = WSP(unsigned, WS_TSEL); float* TW = WSP(float, WS_TW); unsigned* CNTT = WSP(unsigned, WS_CNTT);
        const bf16_t* WRTH = WSP(bf16_t, WS_WRTH); const bf16_t* WRTL = WSP(bf16_t, WS_WRTL);
        LAS float* rstd_s = (LAS float*)(lds);
        LAS unsigned* lcnt = (LAS unsigned*)(lds + 512);
        LAS float* red = (LAS float*)(lds + 1024);
        LAS float* gsl = (LAS float*)(lds + 69632); LAS float* shl = (LAS float*)(lds + 69632 + 8192);
        for (int rg = bx; rg < MTOK / 32; rg += G) {
            const int m0 = rg * 32; const int b = m0 / SEQ; const float* mod = MOD + b * (6 * DM);
            if (tid < 64) lcnt[tid] = 0u;
            { const int c4 = 4 * tid; const f32x4 g = *(const f32x4*)(a.g_ffn + c4), sh = *(const f32x4*)(mod + 3 * DM + c4), sc = *(const f32x4*)(mod + 4 * DM + c4);
              *(LAS f32x4*)(gsl + c4) = g * (sc + 1.0f); *(LAS f32x4*)(shl + c4) = sh; }
            { const int tok = lane & 31, h8 = lane >> 5;
              const float* xrow = X1 + (size_t)(m0 + tok) * DM + wave * 256 + 8 * h8;
              const size_t wo = (size_t)(b * NE + tok) * DM + wave * 256 + 8 * h8;
              f32x16 d0 = {}, d1 = {};
#pragma unroll 4
              for (int ks = 0; ks < 16; ++ks) { const int kk = 16 * ks;
                  const f32x4 ya = *(const f32x4*)(xrow + kk), yb = *(const f32x4*)(xrow + kk + 4);
                  const bf16x8 ah0 = *(const bf16x8*)(WRTH + wo + kk), al0 = *(const bf16x8*)(WRTL + wo + kk), ah1 = *(const bf16x8*)(WRTH + wo + 32 * DM + kk), al1 = *(const bf16x8*)(WRTL + wo + 32 * DM + kk);
                  u32x4 wh, wl;
                  wh.x = cvt_pk_bf16(ya[0], ya[1]); wh.y = cvt_pk_bf16(ya[2], ya[3]); wh.z = cvt_pk_bf16(yb[0], yb[1]); wh.w = cvt_pk_bf16(yb[2], yb[3]);
                  wl.x = cvt_pk_bf16(ya[0] - bf_lo(wh.x), ya[1] - bf_hi(wh.x)); wl.y = cvt_pk_bf16(ya[2] - bf_lo(wh.y), ya[3] - bf_hi(wh.y));
                  wl.z = cvt_pk_bf16(yb[0] - bf_lo(wh.z), yb[1] - bf_hi(wh.z)); wl.w = cvt_pk_bf16(yb[2] - bf_lo(wh.w), yb[3] - bf_hi(wh.w));
                  const bf16x8 bh = __builtin_bit_cast(bf16x8, wh), bl = __builtin_bit_cast(bf16x8, wl);
                  d0 = __builtin_amdgcn_mfma_f32_32x32x16_bf16(ah0, bh, d0, 0, 0, 0); d0 = __builtin_amdgcn_mfma_f32_32x32x16_bf16(al0, bh, d0, 0, 0, 0); d0 = __builtin_amdgcn_mfma_f32_32x32x16_bf16(ah0, bl, d0, 0, 0, 0);
                  d1 = __builtin_amdgcn_mfma_f32_32x32x16_bf16(ah1, bh, d1, 0, 0, 0); d1 = __builtin_amdgcn_mfma_f32_32x32x16_bf16(al1, bh, d1, 0, 0, 0); d1 = __builtin_amdgcn_mfma_f32_32x32x16_bf16(ah1, bl, d1, 0, 0, 0); }
#pragma unroll
              for (int r = 0; r < 16; ++r) { const int e = (r & 3) + 8 * (r >> 2) + 4 * h8; red[(wave * 32 + tok) * 65 + e] = d0[r]; red[(wave * 32 + tok) * 65 + 32 + e] = d1[r]; } }
            __syncthreads();
            { f32x4 v[4][8];
#pragma unroll
              for (int q = 0; q < 4; ++q) { const f32x4* xr = (const f32x4*)(X1 + (size_t)(m0 + wave * 4 + q) * DM) + lane;
#pragma unroll
                  for (int j = 0; j < 8; ++j) v[q][j] = xr[64 * j]; }
#pragma unroll
              for (int q = 0; q < 4; ++q) { float sq = 0.f;
#pragma unroll
                  for (int j = 0; j < 8; ++j) sq += (v[q][j].x * v[q][j].x + v[q][j].y * v[q][j].y) + (v[q][j].z * v[q][j].z + v[q][j].w * v[q][j].w);
                  const int r = wave * 4 + q;
                  const float rstd = 1.0f / sqrtf(wave_sum(sq) * (1.f / DM) + EPS);
                  if (lane == 0) rstd_s[r] = rstd;
                  unsigned* o4 = (unsigned*)(H8 + (size_t)(m0 + r) * DM) + lane;
#pragma unroll
                  for (int j = 0; j < 8; ++j) { const int col = 4 * lane + 256 * j;
                      const f32x4 y = v[q][j] * rstd * *(const LAS f32x4*)(gsl + col) + *(const LAS f32x4*)(shl + col);
                      unsigned w = 0; w = __builtin_amdgcn_cvt_pk_fp8_f32(y.x, y.y, w, false); w = __builtin_amdgcn_cvt_pk_fp8_f32(y.z, y.w, w, true); o4[64 * j] = w; } } }
            __syncthreads();
            const float ebias = a.e_bias[lane], rbias = WSP(float, WS_RBIAS)[b * NE + lane];
#pragma unroll
            for (int rr = 0; rr < 4; ++rr) { const int r = wave * 4 + rr, m = m0 + r;
                float logit = 0.f;
#pragma unroll
                for (int w = 0; w < 8; ++w) logit += red[(w * 32 + r) * 65 + lane];
                logit = logit * rstd_s[r] + rbias;
                const float s = 1.0f / (1.0f + expf(-logit));
                const float sel = s + ebias;
                const float m1 = grp8_max(sel);
                const int cand = grp8_min((sel == m1) ? lane : 64);
                const float m2 = grp8_max((lane == cand) ? -__builtin_inff() : sel);
                const float gs = m1 + m2; const int mygrp = lane >> 3;
                int grank = 0;
#pragma unroll
                for (int g2 = 0; g2 < 8; ++g2) { const float og = lane_bcast(gs, g2 * 8); grank += (og > gs || (og == gs && g2 < mygrp)) ? 1 : 0; }
                const float v = (grank < 4) ? sel : -__builtin_inff();
                int rank = 0;
#pragma unroll
                for (int j = 0; j < 64; ++j) { const float vj = lane_bcast(v, j); rank += (vj > v || (vj == v && j < lane)) ? 1 : 0; }
                const bool chosen = rank < 8;
                const float tot = wave_sum(chosen ? s : 0.f);
                const unsigned long long bal = __ballot(chosen);
                if (chosen) {
                    const unsigned li = __hip_atomic_fetch_add(lcnt + lane, 1u, __ATOMIC_RELAXED, __HIP_MEMORY_SCOPE_WORKGROUP);
                    const int jj = __builtin_popcountll(bal & ((1ull << lane) - 1ull));
                    TSEL[(size_t)m * 8 + jj] = ((unsigned)lane << 16) | li; TW[(size_t)m * 8 + jj] = s / tot * 2.5f;
                }
            }
            __syncthreads();
            if (tid < 64) CNTT[(size_t)rg * 64 + tid] = lcnt[tid];
            __syncthreads();
        }
    }
    SEAM(8);
    if (IN(9)) {
        PHASE_ARGS const unsigned* CNTT = WSP(unsigned, WS_CNTT); unsigned* TSEL = WSP(unsigned, WS_TSEL); const float* TW = WSP(float, WS_TW);
        unsigned* TOK = WSP(unsigned, WS_TOK); float* GATEW = WSP(float, WS_GATE); unsigned* COUNT = WSP(unsigned, WS_CTL) + CW_COUNT;
        LAS unsigned* part = (LAS unsigned*)lds;
        LAS unsigned* base = (LAS unsigned*)(lds + 8192);
        for (int rg = bx; rg < MTOK / 32; rg += G) {
            { const int e = tid & 63, p8 = tid >> 6; unsigned tot = 0, below = 0;
#pragma unroll 8
              for (int i = 0; i < 32; ++i) { const int rg2 = p8 * 32 + i; const unsigned c = CNTT[(size_t)rg2 * 64 + e]; tot += c; below += (rg2 < rg) ? c : 0u; }
              part[(p8 * 64 + e) * 2] = tot; part[(p8 * 64 + e) * 2 + 1] = below; }
            __syncthreads();
            if (tid < 64) { unsigned t = 0, bl = 0;
#pragma unroll
                for (int p = 0; p < 8; ++p) { t += part[(p * 64 + tid) * 2]; bl += part[(p * 64 + tid) * 2 + 1]; }
                base[tid] = bl; if (rg == 0) COUNT[tid] = t; }
            __syncthreads();
            if (tid < 256) { const int m = rg * 32 + (tid >> 3), jj = tid & 7; const unsigned ts = TSEL[(size_t)m * 8 + jj]; const unsigned e2 = ts >> 16, slot = base[e2] + (ts & 0xffffu);
                TOK[(size_t)e2 * ECAP + slot] = (unsigned)m; GATEW[(size_t)e2 * ECAP + slot] = TW[(size_t)m * 8 + jj]; TSEL[(size_t)m * 8 + jj] = (e2 << 16) | slot; }
            __syncthreads();
        }
        bg_fill(a, ws, MISC, -1, G, wave, tid, lane);
    }
    SEAM(9);
    if (IN(10) || IN(11) || IN(12)) {
        PHASE_ARGS const unsigned* COUNT = WSP(unsigned, WS_CTL) + CW_COUNT;
        if (tid < NEX) MISC[MI_CNT + tid] = (tid < NE) ? COUNT[tid] : (unsigned)MTOK;
        __syncthreads();
        if (tid == 0) { unsigned acc = 0; for (int e = 0; e < NEX; ++e) { MISC[MI_TP + e] = acc; acc += (MISC[MI_CNT + e] + 255u) >> 8; } MISC[MI_TP + NEX] = acc; }
        __syncthreads();
    }
    LAS const int* tp = (LAS const int*)(lds + MISC_OFF + 4 * MI_TP); LAS const int* cnt = (LAS const int*)(lds + MISC_OFF + 4 * MI_CNT);
    if (IN(10)) {
        PHASE_ARGS const unsigned char* H = WSP(unsigned char, WS_H); const unsigned char* W13 = WSP(unsigned char, WS_W13); const unsigned* TOK = WSP(unsigned, WS_TOK); const float* GATEW = WSP(float, WS_GATE); unsigned char* HID = WSP(unsigned char, WS_HID);
        MoeSched1 S{(const char*)H, (const char*)W13, TOK, tp, cnt, G, bx, lane};
        pg8::EpiHid E{HID, GATEW, cnt};
        pg8::gemm_phase<pg8::EpiHid, MoeSched1, true, true>(lds, DM, S, E, tid);
    }
    SEAM(10);
    if (IN(11)) {
        PHASE_ARGS const unsigned char* HID = WSP(unsigned char, WS_HID); const unsigned char* W2 = WSP(unsigned char, WS_W2); unsigned char* Y = WSP(unsigned char, WS_Y);
        MoeSched2 S{(const char*)HID, (const char*)W2, tp, G, bx, lane};
        pg8::EpiY E{Y};
        pg8::gemm_phase<pg8::EpiY, MoeSched2, true, true>(lds, DE, S, E, tid);
    }
    SEAM(11);
    if (IN(12)) {
        PHASE_ARGS const float* MOD = WSP(float, WS_MOD); const unsigned char* Y = WSP(unsigned char, WS_Y); const unsigned* TSEL = WSP(unsigned, WS_TSEL);
#pragma unroll 1
        for (int m = gw; m < MTOK; m += NGW) {
            unsigned lo8 = 16u * (unsigned)lane, lo32 = 64u * (unsigned)lane;
            asm volatile("" : "+v"(lo8), "+v"(lo32));
            const int b = m / SEQ; const char* gt2 = (const char*)(MOD + b * (6 * DM) + 5 * DM); const char* gfin = (const char*)a.g_final;
            char* xrow = (char*)(a.out + (size_t)m * DM);
            const u32x4 tsa = *(const u32x4*)(TSEL + (size_t)m * 8), tsb = *(const u32x4*)(TSEL + (size_t)m * 8 + 4);
            const unsigned char* yrow[9];
            { const unsigned tsv[8] = {tsa.x, tsa.y, tsa.z, tsa.w, tsb.x, tsb.y, tsb.z, tsb.w};
#pragma unroll
              for (int k = 0; k < 8; ++k) { const unsigned ts = (unsigned)__builtin_amdgcn_readfirstlane((int)tsv[k]); yrow[k] = Y + ((size_t)tp[ts >> 16] * 256 + (ts & 0xffffu)) * DM; } }
            yrow[8] = Y + ((size_t)tp[NE] * 256 + m) * DM;
            f32x4 sv[2][4];
#pragma unroll
            for (int j = 0; j < 2; ++j)
#pragma unroll
                for (int q = 0; q < 4; ++q) sv[j][q] = (f32x4){0.f, 0.f, 0.f, 0.f};
#define P12_BATCH(K0, KN) do { u32x4 yv[KN][2]; \
            _Pragma("unroll") for (int k = 0; k < KN; ++k) _Pragma("unroll") for (int j = 0; j < 2; ++j) yv[k][j] = *(const u32x4*)(yrow[K0 + k] + lo8 + 1024u * j); \
            _Pragma("unroll") for (int k = 0; k < KN; ++k) _Pragma("unroll") for (int j = 0; j < 2; ++j) _Pragma("unroll") for (int q = 0; q < 4; ++q) { \
                const unsigned w = yv[k][j][q]; const f32x2 lo = __builtin_amdgcn_cvt_pk_f32_fp8(w, false), hi = __builtin_amdgcn_cvt_pk_f32_fp8(w, true); \
                sv[j][q][0] += lo.x; sv[j][q][1] += lo.y; sv[j][q][2] += hi.x; sv[j][q][3] += hi.y; } } while (0)
            P12_BATCH(6, 3); __builtin_amdgcn_sched_barrier(0);
            P12_BATCH(3, 3); __builtin_amdgcn_sched_barrier(0);
            P12_BATCH(0, 3); __builtin_amdgcn_sched_barrier(0);
#undef P12_BATCH
            float ss = 0.f;
#pragma unroll
            for (int j = 0; j < 2; ++j)
#pragma unroll
                for (int q = 0; q < 4; ++q) { const unsigned off = lo32 + 4096u * j + 16u * q; const f32x4 g = *(const f32x4*)(gt2 + off);
                    const f32x4 x2 = *(const f32x4*)(xrow + off) + g * (sv[j][q] * (1.0f / Y8_SCALE)); sv[j][q] = x2;
                    ss += (x2.x * x2.x + x2.y * x2.y) + (x2.z * x2.z + x2.w * x2.w); }
            const float rstd = 1.0f / sqrtf(wave_sum(ss) * (1.f / DM) + EPS);
#pragma unroll
            for (int j = 0; j < 2; ++j)
#pragma unroll
                for (int q = 0; q < 4; ++q) { const unsigned off = lo32 + 4096u * j + 16u * q; *(f32x4*)(xrow + off) = sv[j][q] * rstd * *(const f32x4*)(gfin + off); }
        }
    }
#undef IN
#undef SEAM
}

extern "C" void kernel_launch(void* const* d_in, const int* in_sizes, int n_in, void* d_out, int out_size, void* d_ws, size_t ws_size, hipStream_t stream) {
    static int grid = 0;
    if (grid == 0) {
        if (n_in != 22 || out_size != MTOK * DM || ws_size < WS_END) { fprintf(stderr, "kernel_launch: unexpected shapes (n_in %d out %d ws %zu)\n", n_in, out_size, ws_size); grid = -1; return; }
        int dev = 0, cus = 0;
        if (hipGetDevice(&dev) != hipSuccess || hipDeviceGetAttribute(&cus, hipDeviceAttributeMultiprocessorCount, dev) != hipSuccess) { grid = -1; return; }
        if (hipFuncSetAttribute((const void*)fwd_kernel, hipFuncAttributeMaxDynamicSharedMemorySize, LDS_BYTES) != hipSuccess) { fprintf(stderr, "kernel_launch: hipFuncSetAttribute failed\n"); grid = -1; return; }
        int per_cu = 0;
        if (hipOccupancyMaxActiveBlocksPerMultiprocessor(&per_cu, (const void*)fwd_kernel, NTHREADS, LDS_BYTES) != hipSuccess || per_cu < 1) { fprintf(stderr, "kernel_launch: occupancy query says %d\n", per_cu); }
        (void)hipGetLastError();
        grid = cus;
    }
    if (grid < 0) return;
    (void)hipMemsetAsync((char*)d_ws + WS_CTL, 0, CTL_ZERO_BYTES, stream);
    Args a{};
    const float** pp = (const float**)&a.x;
    for (int i = 0; i < 22; ++i) pp[i] = (const float*)d_in[i];
    a.out = (float*)d_out; a.ws = (unsigned char*)d_ws;
    if (MK_N_LAUNCHES == 1) {
        a.ph_lo = 0; a.ph_hi = NPHASE;
        hipLaunchKernelGGL(fwd_kernel, dim3(grid), dim3(NTHREADS), LDS_BYTES, stream, a);
    } else {
        for (int p = 0; p < NPHASE; ++p) for (int rep = 0; rep < 1 + ((PROBE_REP >> p) & 1); ++rep) {
            a.ph_lo = p; a.ph_hi = p + 1; hipLaunchKernelGGL(fwd_kernel, dim3(grid), dim3(NTHREADS), LDS_BYTES, stream, a); }
    }
}
```

```cpp
#include <hip/hip_runtime.h>
#include <cstdio>
#include <cstdint>

#ifndef MK_N_LAUNCHES
#define MK_N_LAUNCHES 1
#endif

#ifndef PROBE_REP
#define FORCE_NF 3
#define PROBE_REP 0
#endif
#define LAS __attribute__((address_space(3)))
#define GAS __attribute__((address_space(1)))
typedef unsigned short bf16_t;
typedef short bf16x8 __attribute__((ext_vector_type(8)));
typedef short s16x4 __attribute__((ext_vector_type(4)));
typedef float f32x2 __attribute__((ext_vector_type(2)));
typedef float f32x4 __attribute__((ext_vector_type(4)));
typedef float f32x16 __attribute__((ext_vector_type(16)));
typedef unsigned u32x2 __attribute__((ext_vector_type(2)));
typedef unsigned u32x4 __attribute__((ext_vector_type(4)));

constexpr int DM = 2048, NBATCH = 2, SEQ = 4096, MTOK = NBATCH * SEQ, HD = 128;
constexpr int A_COLS = 4608, BQ_OFF = 4608, BK_OFF = 6656, BV_OFF = 7168, GATE_OFF = 7680, IN_COLS = 11776;
constexpr int KAB = 512 + DM;
constexpr int NE = 64, NEX = 65, DE = 512, ECAP = 8192;
constexpr float EPS = 1e-6f;
constexpr float WG_SCALE = 64.0f, WG_DESCALE = 1.0f / 64.0f;
constexpr float W13_SCALE = 64.0f, W13_DESCALE = 1.0f / 64.0f;
constexpr float WO_SCALE = 64.f, MG_SCALE = 64.f, X1_DESCALE = 1.f / (64.f * 64.f);
constexpr float AB_SCALE = 128.f, WAB_SCALE = 64.f;
constexpr float W2_SCALE = 32.0f, HID_SCALE = 16.0f, Y_DESCALE = 1.0f / (32.0f * 16.0f), Y8_SCALE = 16.0f;
constexpr int MOE_ROWS = 90112;

typedef __bf16 bf16x2_t __attribute__((ext_vector_type(2)));
__device__ __forceinline__ unsigned cvt_pk_bf16(float lo, float hi) { const f32x2 v = {lo, hi}; const bf16x2_t b = __builtin_convertvector(v, bf16x2_t); return __builtin_bit_cast(unsigned, b); }
__device__ __forceinline__ u32x4 pack8(f32x4 a, f32x4 b) { u32x4 w; w.x = cvt_pk_bf16(a[0], a[1]); w.y = cvt_pk_bf16(a[2], a[3]); w.z = cvt_pk_bf16(b[0], b[1]); w.w = cvt_pk_bf16(b[2], b[3]); return w; }
__device__ __forceinline__ float bf_lo(unsigned w) { return __uint_as_float(w << 16); }
__device__ __forceinline__ float bf_hi(unsigned w) { return __uint_as_float(w & 0xffff0000u); }
__device__ __forceinline__ void unpack8(u32x4 w, f32x4& a, f32x4& b) { a[0] = bf_lo(w.x); a[1] = bf_hi(w.x); a[2] = bf_lo(w.y); a[3] = bf_hi(w.y); b[0] = bf_lo(w.z); b[1] = bf_hi(w.z); b[2] = bf_lo(w.w); b[3] = bf_hi(w.w); }
__device__ __forceinline__ unsigned f2bf(float f) { unsigned u = __float_as_uint(f); return (u + 0x7fffu + ((u >> 16) & 1u)) >> 16; }
__device__ __forceinline__ float bf2f(bf16_t h) { return __uint_as_float(((unsigned)h) << 16); }
__device__ __forceinline__ float fast_sigmoid(float x) { return __builtin_amdgcn_rcpf(1.0f + __builtin_amdgcn_exp2f(-1.4426950408889634f * x)); }

__device__ __forceinline__ int lane_id() { return (int)(threadIdx.x & 63u); }
namespace pg8 {
constexpr int BM = 256, BK = 64, HALF = 128, HTB = HALF * BK * 2, STAGE_BYTES = 8 * HTB, NXCD = 8, WGM = 8;
__host__ __device__ __forceinline__ int lds_byte(int r, int c) { const int st = (r >> 4) * 2 + (c >> 5), rr = r & 15, cc = c & 31, ob = rr * 64 + cc * 2; return st * 1024 + (ob ^ (((ob >> 9) & 1) << 5)); }
__host__ __device__ __forceinline__ void stage_rc(int b, int& R, int& C) { const int st = b / 1024, sb = b % 1024, swz = sb ^ (((sb >> 9) & 1) << 5); R = (st >> 1) * 16 + swz / 64; C = (st & 1) * 32 + (swz % 64) / 2; }
__host__ __device__ __forceinline__ int perm32(int rho) { const int n = rho >> 4, i = rho & 15; return 8 * (i >> 2) + 4 * n + (i & 3); }

struct Unit { int pm, pn, e, aux; };

struct StaticOrder {
    int nM, nN, nwg, G, c;
    __device__ void init(int M, int N, int G_, int c_) { nM = M / BM; nN = N / BM; nwg = nM * nN; G = G_; c = c_; }
    __device__ bool next(int i, Unit& u) const {
        const long L = (long)i * G + c; if (L >= nwg) return false;
        int wgid = (int)L; { const int q = nwg / NXCD, r = nwg % NXCD, xcd = wgid % NXCD, off = wgid / NXCD; wgid = (xcd < r ? xcd * (q + 1) : r * (q + 1) + (xcd - r) * q) + off; }
        const int nig = WGM * nN, gid = wgid / nig, fm = gid * WGM, gsz = (nM - fm) < WGM ? (nM - fm) : WGM;
        u.pm = fm + ((wgid % nig) % gsz); u.pn = (wgid % nig) / gsz; u.e = 0; u.aux = 0; return true;
    }
};
struct DenseSched {
    static constexpr bool GATHER = false;
    const char* A; const char* Bt; int K; StaticOrder o;
    __device__ __forceinline__ bool next(int i, Unit& u) const { return o.next(i, u); }
    __device__ __forceinline__ const char* a_tile(const Unit& u) const { return A + (size_t)u.pm * (BM * 2) * K; }
    __device__ __forceinline__ const char* b_tile(const Unit& u) const { return Bt + (size_t)u.pn * (BM * 2) * K; }
    __device__ __forceinline__ void a_voff(const Unit&, const int (&R)[2], const int (&C)[2], unsigned (&v)[2][2]) const {
#pragma unroll
        for (int h = 0; h < 2; ++h)
#pragma unroll
            for (int i = 0; i < 2; ++i) v[h][i] = (unsigned)((R[i] + HALF * h) * K + C[i]) * 2u;
    }
};
struct DenseSched8 {
    static constexpr bool GATHER = false;
    const char* A; const char* Bt; int K; StaticOrder o;
    __device__ __forceinline__ bool next(int i, Unit& u) const { return o.next(i, u); }
    __device__ __forceinline__ const char* a_tile(const Unit& u) const { return A + (size_t)u.pm * BM * K; }
    __device__ __forceinline__ const char* b_tile(const Unit& u) const { return Bt + (size_t)u.pn * BM * K; }
    __device__ __forceinline__ void a_voff(const Unit&, const int (&R)[2], const int (&C)[2], unsigned (&v)[2][2]) const {
#pragma unroll
        for (int h = 0; h < 2; ++h)
#pragma unroll
            for (int i = 0; i < 2; ++i) v[h][i] = (unsigned)((R[i] + HALF * h) * K + C[i] * 2);
    }
};
typedef int v8i32 __attribute__((ext_vector_type(8)));
typedef short s16x16 __attribute__((ext_vector_type(16)));
__device__ __forceinline__ v8i32 cat16(bf16x8 lo, bf16x8 hi) { const s16x16 c = __builtin_shufflevector(lo, hi, 0, 1, 2, 3, 4, 5, 6, 7, 8, 9, 10, 11, 12, 13, 14, 15); return __builtin_bit_cast(v8i32, c); }

template <class Epi, class Sched, bool ALIGN_EPI, bool FP8 = false>
__device__ __forceinline__ void gemm_phase(LAS unsigned char* lds, const int KB, const Sched& S, const Epi& E, const int tid) {
    const int wid = __builtin_amdgcn_readfirstlane(tid >> 6), lane = tid & 63, wr = wid >> 2, wc = wid & 3, fr = lane & 15, fq = lane >> 4;
    const int nt = KB / (BK * 2);
    int Rr[2], Cc[2]; unsigned voffB[2];
#pragma unroll
    for (int i = 0; i < 2; ++i) { int R, C; stage_rc(tid * 16 + i * 8192, R, C); Rr[i] = R; Cc[i] = C; const int Rb = (R & ~31) + perm32(R & 31); voffB[i] = (unsigned)(Rb * KB + C * 2); }
    const size_t kstep = (size_t)(BK * 2);
    const size_t hstep = (size_t)HALF * KB;
    const unsigned ldsw = (unsigned)wid * 1024u;
    const int aoff = lds_byte(wr * 64 + fr, fq * 8), boff = lds_byte(wc * 32 + fr, fq * 8);
#define PG8_SA(b, h) (((b) * 2 + (h)) * HTB)
#define PG8_SB(b, h) ((4 + (b) * 2 + (h)) * HTB)
#define PG8_STAGE(bufoff, gbase, voff) do { _Pragma("unroll") for (int _i = 0; _i < 2; ++_i) \
        __builtin_amdgcn_global_load_lds((const unsigned*)((const char*)(gbase) + (voff)[_i]), (LAS unsigned*)(lds + (bufoff) + ldsw + _i * 8192), 16, 0, 0); } while (0)
#define PG8_LDA(dst, b, h) do { _Pragma("unroll") for (int m = 0; m < 4; ++m) dst[m] = cat16(*(const LAS bf16x8*)(lds + PG8_SA(b, h) + aoff + m * 2048), *(const LAS bf16x8*)(lds + PG8_SA(b, h) + aoff + m * 2048 + 1024)); } while (0)
#define PG8_LDB(dst, b, h) do { _Pragma("unroll") for (int n = 0; n < 2; ++n) dst[n] = cat16(*(const LAS bf16x8*)(lds + PG8_SB(b, h) + boff + n * 2048), *(const LAS bf16x8*)(lds + PG8_SB(b, h) + boff + n * 2048 + 1024)); } while (0)
#define PG8_LO(x) __builtin_bit_cast(bf16x8, __builtin_shufflevector(x, x, 0, 1, 2, 3))
#define PG8_HI(x) __builtin_bit_cast(bf16x8, __builtin_shufflevector(x, x, 4, 5, 6, 7))
#define PG8_MMA(ai, bj, At, Bt) do { __builtin_amdgcn_s_setprio(1); \
        if constexpr (FP8) { _Pragma("unroll") for (int m = 0; m < 4; ++m) _Pragma("unroll") for (int n = 0; n < 2; ++n) \
            asm volatile("v_mfma_scale_f32_16x16x128_f8f6f4 %0, %1, %2, %0, %3, %3 op_sel_hi:[0,0,0]" : "+v"(acc[ai][bj][m][n]) : "v"(Bt[n]), "v"(At[m]), "v"(one_scale)); } \
        else { _Pragma("unroll") for (int m = 0; m < 4; ++m) _Pragma("unroll") for (int n = 0; n < 2; ++n) { \
            acc[ai][bj][m][n] = __builtin_amdgcn_mfma_f32_16x16x32_bf16(PG8_LO(Bt[n]), PG8_LO(At[m]), acc[ai][bj][m][n], 0, 0, 0); \
            acc[ai][bj][m][n] = __builtin_amdgcn_mfma_f32_16x16x32_bf16(PG8_HI(Bt[n]), PG8_HI(At[m]), acc[ai][bj][m][n], 0, 0, 0); } } \
        __builtin_amdgcn_s_setprio(0); } while (0)
#define PG8_WAIT_V(n) asm volatile("s_waitcnt vmcnt(" #n ")" ::: "memory")
#define PG8_WAIT_L(n) asm volatile("s_waitcnt lgkmcnt(" #n ")" ::: "memory")
#define PG8_BAR __builtin_amdgcn_s_barrier()
#define PG8_SCHED __builtin_amdgcn_sched_barrier(0)
    Unit cur, nxt; int ui = 0;
    if (!S.next(0, cur)) return;
    f32x4 acc[2][2][4][2];
#pragma unroll
    for (int a = 0; a < 2; ++a)
#pragma unroll
        for (int b = 0; b < 2; ++b)
#pragma unroll
            for (int m = 0; m < 4; ++m)
#pragma unroll
                for (int n = 0; n < 2; ++n) acc[a][b][m][n] = (f32x4){0.f, 0.f, 0.f, 0.f};
    v8i32 At[4], B0[2], B1[2];
    const int one_scale = 0x7f7f7f7f; (void)one_scale;
    unsigned vA[2][2], vN[2][2];
    S.a_voff(cur, Rr, Cc, vA);
    const char* cA = S.a_tile(cur); const char* cB = S.b_tile(cur);
    PG8_STAGE(PG8_SB(0, 0), cB, voffB); PG8_STAGE(PG8_SB(0, 1), cB + hstep, voffB); PG8_STAGE(PG8_SA(0, 0), cA, vA[0]); PG8_STAGE(PG8_SA(0, 1), cA, vA[1]);
    if (wr == 1) PG8_BAR;
    PG8_WAIT_V(2); PG8_BAR;
    PG8_STAGE(PG8_SB(1, 0), cB + kstep, voffB); PG8_STAGE(PG8_SA(1, 0), cA + kstep, vA[0]); PG8_STAGE(PG8_SB(1, 1), cB + hstep + kstep, voffB);
    PG8_WAIT_V(6); PG8_BAR;
    for (;;) {
        const bool has_next = S.next(ui + 1, nxt);
        const char* nA = cA; const char* nB = cB;
        if constexpr (Sched::GATHER) {
#pragma unroll
            for (int h = 0; h < 2; ++h)
#pragma unroll
                for (int i = 0; i < 2; ++i) vN[h][i] = vA[h][i];
        }
        if (has_next) { nA = S.a_tile(nxt); nB = S.b_tile(nxt); if constexpr (Sched::GATHER) S.a_voff(nxt, Rr, Cc, vN); }
#pragma unroll 1
        for (int t = 0; t < nt; t += 2) {
            const bool last = (t == nt - 2);
            if constexpr (Epi::MID_T > 0) { if (t == Epi::MID_T) { int fr_ = fr, fq_ = fq; asm volatile("" : "+v"(fr_), "+v"(fq_)); E.mid(acc, cur, wr, wc, fr_, fq_); } }
            const char* a1 = cA + (size_t)(t + 1) * kstep;
            const char* a2 = last ? nA : cA + (size_t)(t + 2) * kstep; const char* b2 = last ? nB : cB + (size_t)(t + 2) * kstep;
            const char* a3 = a2 + kstep; const char* b3 = b2 + kstep;
            unsigned v2[2][2];
#pragma unroll
            for (int h = 0; h < 2; ++h)
#pragma unroll
                for (int i = 0; i < 2; ++i) { if constexpr (Sched::GATHER) v2[h][i] = last ? vN[h][i] : vA[h][i]; else v2[h][i] = vA[h][i]; }
            PG8_LDB(B0, 0, 0); PG8_LDB(B1, 0, 1); PG8_SCHED; PG8_LDA(At, 0, 0); PG8_STAGE(PG8_SA(1, 1), a1, vA[1]);
            PG8_WAIT_V(8); PG8_WAIT_L(0); PG8_BAR; PG8_MMA(0, 0, At, B0); PG8_MMA(0, 1, At, B1); PG8_BAR; PG8_SCHED;
            PG8_LDA(At, 0, 1); PG8_STAGE(PG8_SB(0, 0), b2, voffB); PG8_STAGE(PG8_SB(0, 1), b2 + hstep, voffB); PG8_STAGE(PG8_SA(0, 0), a2, v2[0]);
            PG8_WAIT_V(8); PG8_WAIT_L(0); PG8_BAR; PG8_MMA(1, 0, At, B0); PG8_MMA(1, 1, At, B1); PG8_BAR; PG8_SCHED;
            PG8_LDB(B0, 1, 0); PG8_LDB(B1, 1, 1); PG8_SCHED; PG8_LDA(At, 1, 0); PG8_STAGE(PG8_SA(0, 1), a2, v2[1]);
            PG8_WAIT_V(8); PG8_WAIT_L(0); PG8_BAR; PG8_MMA(0, 0, At, B0); PG8_MMA(0, 1, At, B1); PG8_BAR; PG8_SCHED;
            PG8_LDA(At, 1, 1); PG8_STAGE(PG8_SB(1, 0), b3, voffB); PG8_STAGE(PG8_SB(1, 1), b3 + hstep, voffB); PG8_STAGE(PG8_SA(1, 0), a3, v2[0]);
            PG8_WAIT_V(8); PG8_WAIT_L(0); PG8_BAR; PG8_MMA(1, 0, At, B0); PG8_MMA(1, 1, At, B1); PG8_BAR; PG8_SCHED;
        }
        if constexpr (ALIGN_EPI) { if (wr == 0) PG8_BAR; }
        if constexpr (FP8) asm volatile("s_nop 15\n\ts_nop 15" ::: "memory");
        if constexpr (Epi::PRE != 1.0f) {
#pragma unroll
            for (int a = 0; a < 2; ++a)
#pragma unroll
                for (int b = 0; b < 2; ++b)
#pragma unroll
                    for (int m = 0; m < 4; ++m)
#pragma unroll
                        for (int n = 0; n < 2; ++n) acc[a][b][m][n] *= Epi::PRE; }
        { int fr_ = fr, fq_ = fq; asm volatile("" : "+v"(fr_), "+v"(fq_));
          E(acc, cur, wr, wc, fr_, fq_); }
        if (!has_next) break;
#pragma unroll
        for (int a = 0; a < 2; ++a)
#pragma unroll
            for (int b = 0; b < 2; ++b)
#pragma unroll
                for (int m = 0; m < 4; ++m)
#pragma unroll
                    for (int n = 0; n < 2; ++n) acc[a][b][m][n] = (f32x4){0.f, 0.f, 0.f, 0.f};
        cur = nxt; cA = nA; cB = nB; ++ui;
        if constexpr (Sched::GATHER) {
#pragma unroll
            for (int h = 0; h < 2; ++h)
#pragma unroll
                for (int i = 0; i < 2; ++i) vA[h][i] = vN[h][i];
        }
        if constexpr (ALIGN_EPI) { if (wr == 1) PG8_BAR; }
    }
    PG8_WAIT_V(0);
    if constexpr (!ALIGN_EPI) { if (wr == 0) PG8_BAR; }
    PG8_BAR;
#undef PG8_SA
#undef PG8_SB
#undef PG8_STAGE
#undef PG8_LDA
#undef PG8_LDB
#undef PG8_LO
#undef PG8_HI
#undef PG8_MMA
#undef PG8_WAIT_V
#undef PG8_WAIT_L
#undef PG8_BAR
#undef PG8_SCHED
}

#define EPI_LOOP_ROWS for (int ai = 0; ai < 2; ++ai) _Pragma("unroll") for (int m = 0; m < 4; ++m)
struct EpiProj {
    static constexpr int MID_T = 0; static constexpr float PRE = 1.0f / WG_SCALE;
    bf16_t* O; const float* bgate; const float* ropeA; const float* ropeB; const float* qg; const float* kg; LAS float* xs; unsigned char* vt; unsigned char* k8;
    __device__ __forceinline__ void operator()(const f32x4 (&acc)[2][2][4][2], const Unit& u, int wr, int wc, int fr, int fq) const {
        const int row0 = u.pm * BM + wr * 64 + fr, colt = u.pn * BM, c0 = colt + wc * 32 + 8 * fq;
        if (colt >= GATE_OFF) {
            f32x4 bv[2][2];
#pragma unroll
            for (int bj = 0; bj < 2; ++bj)
#pragma unroll
                for (int n = 0; n < 2; ++n) bv[bj][n] = *(const f32x4*)(bgate + (c0 - GATE_OFF) + bj * HALF + 4 * n);
#pragma unroll
            EPI_LOOP_ROWS { bf16_t* rowp = O + (size_t)(row0 + ai * HALF + m * 16) * IN_COLS + c0;
#pragma unroll
                for (int bj = 0; bj < 2; ++bj) { f32x4 v0 = acc[ai][bj][m][0] + bv[bj][0], v1 = acc[ai][bj][m][1] + bv[bj][1];
#pragma unroll
                    for (int j = 0; j < 4; ++j) { v0[j] = fast_sigmoid(v0[j]); v1[j] = fast_sigmoid(v1[j]); }
                    *(u32x4*)(rowp + bj * HALF) = pack8(v0, v1); } }
        } else if (colt >= BQ_OFF && colt < BV_OFF) {
#pragma unroll
            EPI_LOOP_ROWS {
#pragma unroll
                for (int bj = 0; bj < 2; ++bj) { const f32x4 a0 = acc[ai][bj][m][0], a1 = acc[ai][bj][m][1];
                    float sq = (a0[0] * a0[0] + a0[1] * a0[1]) + (a0[2] * a0[2] + a0[3] * a0[3]) + (a1[0] * a1[0] + a1[1] * a1[1]) + (a1[2] * a1[2] + a1[3] * a1[3]);
                    sq += __uint_as_float((unsigned)__builtin_amdgcn_ds_swizzle((int)__float_as_uint(sq), (16 << 10) | 0x1f));
                    { auto rr = __builtin_amdgcn_permlane32_swap(__float_as_uint(sq), __float_as_uint(sq), false, false); sq = __uint_as_float(rr[0]) + __uint_as_float(rr[1]); }
                    if (fq == 0) xs[((ai * HALF + wr * 64 + m * 16 + fr) * 2 + bj) * 4 + wc] = sq; } }
            asm volatile("s_waitcnt lgkmcnt(0)" ::: "memory"); __builtin_amdgcn_s_barrier(); asm volatile("" ::: "memory");
            const int half = wc >> 1, jb = 16 * (wc & 1) + 4 * fq;
            const float* gn = (colt >= BK_OFF) ? kg : qg;
            const f32x4 g1 = *(const f32x4*)(gn + 64 * half + jb), g2 = *(const f32x4*)(gn + 64 * half + 32 + jb);
#pragma unroll
            EPI_LOOP_ROWS { const int row = row0 + ai * HALF + m * 16, t = row & (SEQ - 1), pos = half ? (t & 63) : (t >> 6);
                const f32x4 cs0 = *(const f32x4*)(ropeB + ((size_t)pos * 32 + jb) * 2), cs1 = *(const f32x4*)(ropeB + ((size_t)pos * 32 + jb) * 2 + 4);
                bf16_t* rowp = O + (size_t)row * IN_COLS + c0;
#pragma unroll
                for (int bj = 0; bj < 2; ++bj) { const f32x4 p = *(const LAS f32x4*)(xs + ((ai * HALF + wr * 64 + m * 16 + fr) * 2 + bj) * 4);
                    const float rstd = 1.0f / sqrtf(((p[0] + p[1]) + (p[2] + p[3])) * (1.f / HD) + EPS);
                    const f32x4 a0 = acc[ai][bj][m][0] * rstd, a1 = acc[ai][bj][m][1] * rstd; f32x4 o0, o1;
                    { const float x1 = a0[0] * g1[0], x2 = a0[1] * g2[0]; o0[0] = x1 * cs0[0] - x2 * cs0[1]; o0[1] = x2 * cs0[0] + x1 * cs0[1]; }
                    { const float x1 = a0[2] * g1[1], x2 = a0[3] * g2[1]; o0[2] = x1 * cs0[2] - x2 * cs0[3]; o0[3] = x2 * cs0[2] + x1 * cs0[3]; }
                    { const float x1 = a1[0] * g1[2], x2 = a1[1] * g2[2]; o1[0] = x1 * cs1[0] - x2 * cs1[1]; o1[1] = x2 * cs1[0] + x1 * cs1[1]; }
                    { const float x1 = a1[2] * g1[3], x2 = a1[3] * g2[3]; o1[2] = x1 * cs1[2] - x2 * cs1[3]; o1[3] = x2 * cs1[2] + x1 * cs1[3]; }
                    if (colt >= BK_OFF) {
                        unsigned lo = 0, hi8 = 0;
                        lo = __builtin_amdgcn_cvt_pk_fp8_f32(o0[0], o0[1], lo, false); lo = __builtin_amdgcn_cvt_pk_fp8_f32(o0[2], o0[3], lo, true);
                        hi8 = __builtin_amdgcn_cvt_pk_fp8_f32(o1[0], o1[1], hi8, false); hi8 = __builtin_amdgcn_cvt_pk_fp8_f32(o1[2], o1[3], hi8, true);
                        *(u32x2*)(k8 + ((size_t)((row / SEQ) * 4 + (colt - BK_OFF) / HD + bj) * SEQ + (row & (SEQ - 1))) * HD + wc * 32 + 8 * fq) = (u32x2){lo, hi8}; }
                    else *(u32x4*)(rowp + bj * HALF) = pack8(o0, o1); } }
        } else {
            if (colt >= BV_OFF) {
#pragma unroll
                EPI_LOOP_ROWS { const int row = row0 + ai * HALF + m * 16;
                    unsigned char* vp = vt + ((size_t)((row / SEQ) * 4 + (colt - BV_OFF) / HD) * HD + wc * 32 + 8 * fq) * SEQ + (row & (SEQ - 1));
#pragma unroll
                    for (int bj = 0; bj < 2; ++bj)
#pragma unroll
                        for (int n = 0; n < 2; ++n) { const f32x4 v = acc[ai][bj][m][n];
                            const unsigned w0 = __builtin_amdgcn_cvt_pk_fp8_f32(v[0], v[1], 0u, false), w1 = __builtin_amdgcn_cvt_pk_fp8_f32(v[2], v[3], 0u, false);
                            unsigned char* q = vp + (size_t)(bj * HD + 4 * n) * SEQ;
                            q[0] = (unsigned char)(w0 & 0xffu); q[SEQ] = (unsigned char)((w0 >> 8) & 0xffu); q[2 * SEQ] = (unsigned char)(w1 & 0xffu); q[3 * SEQ] = (unsigned char)((w1 >> 8) & 0xffu); } }
                return; }
            const bool ropea = colt < A_COLS && (u.pn % 6) < 4 && wc == 0;
#pragma unroll
            EPI_LOOP_ROWS { const int row = row0 + ai * HALF + m * 16; bf16_t* rowp = O + (size_t)row * IN_COLS + c0;
                f32x4 cs0 = {1.f, 0.f, 1.f, 0.f}, cs1 = {1.f, 0.f, 1.f, 0.f};
                if (ropea) { const int t = row & (SEQ - 1); cs0 = *(const f32x4*)(ropeA + ((size_t)t * 16 + 4 * fq) * 2); cs1 = *(const f32x4*)(ropeA + ((size_t)t * 16 + 4 * fq) * 2 + 4); }
#pragma unroll
                for (int bj = 0; bj < 2; ++bj) { const f32x4 a0 = acc[ai][bj][m][0], a1 = acc[ai][bj][m][1]; f32x4 o0, o1;
                    o0[0] = a0[0] * cs0[0] - a0[1] * cs0[1]; o0[1] = a0[1] * cs0[0] + a0[0] * cs0[1]; o0[2] = a0[2] * cs0[2] - a0[3] * cs0[3]; o0[3] = a0[3] * cs0[2] + a0[2] * cs0[3];
                    o1[0] = a1[0] * cs1[0] - a1[1] * cs1[1]; o1[1] = a1[1] * cs1[0] + a1[0] * cs1[1]; o1[2] = a1[2] * cs1[2] - a1[3] * cs1[3]; o1[3] = a1[3] * cs1[2] + a1[2] * cs1[3];
                    *(u32x4*)(rowp + bj * HALF) = pack8(o0, o1); } }
        }
    }
};
struct EpiGate {
    static constexpr int MID_T = 0; static constexpr float PRE = 1.0f;
    bf16_t* O; const float* bgate;
    __device__ __forceinline__ void operator()(const f32x4 (&acc)[2][2][4][2], const Unit& u, int wr, int wc, int fr, int fq) const {
        const int row0 = u.pm * BM + wr * 64 + fr, c0 = u.pn * BM + wc * 32 + 8 * fq;
        f32x4 bv[2][2];
#pragma unroll
        for (int bj = 0; bj < 2; ++bj)
#pragma unroll
            for (int n = 0; n < 2; ++n) bv[bj][n] = *(const f32x4*)(bgate + c0 + bj * HALF + 4 * n);
#pragma unroll
        EPI_LOOP_ROWS { bf16_t* rowp = O + (size_t)(row0 + ai * HALF + m * 16) * IN_COLS + GATE_OFF + c0;
#pragma unroll
            for (int bj = 0; bj < 2; ++bj) { f32x4 v0 = acc[ai][bj][m][0] * WG_DESCALE + bv[bj][0], v1 = acc[ai][bj][m][1] * WG_DESCALE + bv[bj][1];
#pragma unroll
                for (int j = 0; j < 4; ++j) { v0[j] = fast_sigmoid(v0[j]); v1[j] = fast_sigmoid(v1[j]); }
                *(u32x4*)(rowp + bj * HALF) = pack8(v0, v1); } }
    }
};
struct EpiMerged2 {
    static constexpr int MID_T = 4; static constexpr float PRE = 1.0f;
    unsigned char* O; const bf16_t* P;
    __device__ __forceinline__ void mid(f32x4 (&acc)[2][2][4][2], const Unit& u, int wr, int wc, int fr, int fq) const {
        const int row0 = u.pm * BM + wr * 64 + fr, c0 = u.pn * BM + wc * 32 + 8 * fq;
#pragma unroll
        EPI_LOOP_ROWS { const size_t r = (size_t)(row0 + ai * HALF + m * 16);
#pragma unroll
            for (int bj = 0; bj < 2; ++bj) { const int c = c0 + bj * HALF; f32x4 a0, a1, b0, b1;
                unpack8(*(const u32x4*)(P + r * IN_COLS + GATE_OFF + c), a0, a1); unpack8(*(const u32x4*)(P + r * IN_COLS + GATE_OFF + DM + c), b0, b1);
#pragma unroll
                for (int j = 0; j < 4; ++j) { acc[ai][bj][m][0][j] *= a0[j] * __builtin_amdgcn_rcpf(fmaxf(b0[j], 1e-30f)); acc[ai][bj][m][1][j] *= a1[j] * __builtin_amdgcn_rcpf(fmaxf(b1[j], 1e-30f)); } } }
    }
    __device__ __forceinline__ void operator()(const f32x4 (&acc)[2][2][4][2], const Unit& u, int wr, int wc, int fr, int fq) const {
        const int row0 = u.pm * BM + wr * 64 + fr, c0 = u.pn * BM + wc * 32 + 8 * fq;
        constexpr float MGS = MG_SCALE / (AB_SCALE * WAB_SCALE);
#pragma unroll
        EPI_LOOP_ROWS { const size_t r = (size_t)(row0 + ai * HALF + m * 16);
#pragma unroll
            for (int bj = 0; bj < 2; ++bj) { const int c = c0 + bj * HALF; f32x4 g0, g1; unpack8(*(const u32x4*)(P + r * IN_COLS + GATE_OFF + DM + c), g0, g1);
#pragma unroll
                for (int j = 0; j < 4; ++j) { g0[j] = fmaxf(g0[j], 1e-30f); g1[j] = fmaxf(g1[j], 1e-30f); }
                f32x4 v0 = acc[ai][bj][m][0] * g0 * MGS, v1 = acc[ai][bj][m][1] * g1 * MGS; unsigned lo = 0, hi = 0;
#pragma unroll
                for (int j = 0; j < 4; ++j) { v0[j] = __builtin_amdgcn_fmed3f(v0[j], -448.f, 448.f); v1[j] = __builtin_amdgcn_fmed3f(v1[j], -448.f, 448.f); }
                lo = __builtin_amdgcn_cvt_pk_fp8_f32(v0[0], v0[1], lo, false); lo = __builtin_amdgcn_cvt_pk_fp8_f32(v0[2], v0[3], lo, true);
                hi = __builtin_amdgcn_cvt_pk_fp8_f32(v1[0], v1[1], hi, false); hi = __builtin_amdgcn_cvt_pk_fp8_f32(v1[2], v1[3], hi, true);
                *(u32x2*)(O + r * DM + c) = (u32x2){lo, hi}; } }
    }
};
struct EpiX1 {
    static constexpr int MID_T = 0; static constexpr float PRE = 1.0f;
    float* X1; const float* x; const float* mod;
    __device__ __forceinline__ void operator()(const f32x4 (&acc)[2][2][4][2], const Unit& u, int wr, int wc, int fr, int fq) const {
        const int row0 = u.pm * BM + wr * 64 + fr, c0 = u.pn * BM + wc * 32 + 8 * fq;
        const float* gt = mod + (size_t)((u.pm * BM) / SEQ) * (6 * DM) + 2 * DM;
        f32x4 gv[2][2];
#pragma unroll
        for (int bj = 0; bj < 2; ++bj)
#pragma unroll
            for (int n = 0; n < 2; ++n) gv[bj][n] = *(const f32x4*)(gt + c0 + bj * HALF + 4 * n) * X1_DESCALE;
#pragma unroll
        EPI_LOOP_ROWS { const size_t r = (size_t)(row0 + ai * HALF + m * 16);
#pragma unroll
            for (int bj = 0; bj < 2; ++bj)
#pragma unroll
                for (int n = 0; n < 2; ++n) { const int c = c0 + bj * HALF + 4 * n; *(f32x4*)(X1 + r * DM + c) = *(const f32x4*)(x + r * DM + c) + gv[bj][n] * acc[ai][bj][m][n]; } }
    }
};
struct EpiHid {
    static constexpr int MID_T = 0; static constexpr float PRE = 1.0f;
    unsigned char* HID; const float* gate_of; LAS const int* cnt;
    __device__ __forceinline__ void operator()(const f32x4 (&acc)[2][2][4][2], const Unit& u, int wr, int wc, int fr, int fq) const {
        const int row0 = u.pm * BM + wr * 64 + fr, c0 = u.pn * HALF + wc * 32 + 8 * fq;
        const int ce = cnt[u.e];
#pragma unroll
        EPI_LOOP_ROWS { const int rr = ai * HALF + m * 16; const int slot = u.aux + wr * 64 + fr + rr;
            float g = HID_SCALE; if (u.e < NE) g = slot < ce ? gate_of[(size_t)u.e * ECAP + slot] * HID_SCALE : 0.f;
            f32x4 h0, h1;
#pragma unroll
            for (int j = 0; j < 4; ++j) { const float a0 = acc[ai][0][m][0][j] * W13_DESCALE, a1 = acc[ai][0][m][1][j] * W13_DESCALE;
                h0[j] = g * a0 * fast_sigmoid(a0) * (acc[ai][1][m][0][j] * W13_DESCALE); h1[j] = g * a1 * fast_sigmoid(a1) * (acc[ai][1][m][1][j] * W13_DESCALE); }
#pragma unroll
            for (int j = 0; j < 4; ++j) { h0[j] = __builtin_amdgcn_fmed3f(h0[j], -448.f, 448.f); h1[j] = __builtin_amdgcn_fmed3f(h1[j], -448.f, 448.f); }
            unsigned lo = 0, hi = 0;
            lo = __builtin_amdgcn_cvt_pk_fp8_f32(h0[0], h0[1], lo, false); lo = __builtin_amdgcn_cvt_pk_fp8_f32(h0[2], h0[3], lo, true);
            hi = __builtin_amdgcn_cvt_pk_fp8_f32(h1[0], h1[1], hi, false); hi = __builtin_amdgcn_cvt_pk_fp8_f32(h1[2], h1[3], hi, true);
            *(u32x2*)(HID + (size_t)(row0 + rr) * DE + c0) = (u32x2){lo, hi}; }
    }
};
struct EpiY {
    static constexpr int MID_T = 0; static constexpr float PRE = 1.0f;
    unsigned char* Y;
    __device__ __forceinline__ void operator()(const f32x4 (&acc)[2][2][4][2], const Unit& u, int wr, int wc, int fr, int fq) const {
        const int od = fq & 1;
        const int row0 = u.pm * BM + wr * 64 + fr + 16 * od, c0 = u.pn * BM + wc * 32 + 8 * (fq - od);
        constexpr float sc = Y_DESCALE * Y8_SCALE;
#pragma unroll
        for (int ai = 0; ai < 2; ++ai)
#pragma unroll
            for (int mp = 0; mp < 2; ++mp) { unsigned char* rowp = Y + (size_t)(row0 + ai * HALF + mp * 32) * DM + c0;
#pragma unroll
                for (int bj = 0; bj < 2; ++bj) { unsigned w[2][2];
#pragma unroll
                    for (int k = 0; k < 2; ++k) { f32x4 v0 = acc[ai][bj][2 * mp + k][0] * sc, v1 = acc[ai][bj][2 * mp + k][1] * sc; unsigned lo = 0, hi = 0;
#pragma unroll
                        for (int j = 0; j < 4; ++j) { v0[j] = __builtin_amdgcn_fmed3f(v0[j], -448.f, 448.f); v1[j] = __builtin_amdgcn_fmed3f(v1[j], -448.f, 448.f); }
                        lo = __builtin_amdgcn_cvt_pk_fp8_f32(v0[0], v0[1], lo, false); lo = __builtin_amdgcn_cvt_pk_fp8_f32(v0[2], v0[3], lo, true);
                        hi = __builtin_amdgcn_cvt_pk_fp8_f32(v1[0], v1[1], hi, false); hi = __builtin_amdgcn_cvt_pk_fp8_f32(v1[2], v1[3], hi, true);
                        w[k][0] = lo; w[k][1] = hi; }
                    const auto s0 = __builtin_amdgcn_permlane16_swap(w[0][0], w[1][0], false, false), s1 = __builtin_amdgcn_permlane16_swap(w[0][1], w[1][1], false, false);
                    *(u32x4*)(rowp + bj * HALF) = (u32x4){s0[0], s1[0], s0[1], s1[1]}; } }
    }
};
}

namespace att {
constexpr int D = 128, NW = 8, QBLK = 32, KVBLK = 64;
constexpr float SCALE = 0.088388347648318440f;
constexpr float THR = 8.f;
constexpr size_t SHM_V = KVBLK * D * 2, SHM_K = KVBLK * D * 2, SHM_ATTN = 2 * SHM_V + 2 * SHM_K + NW * 64 * 4;
#define KSWZ(row, colB) ((row) * 256 + ((colB) ^ (((row) & 7) << 4)))
#define SBAR() __builtin_amdgcn_sched_barrier(0)
__device__ __forceinline__ int crow(int r, int hi) { return (r & 3) + 8 * (r >> 2) + 4 * hi; }
__device__ __forceinline__ unsigned cvtpk(float lo, float hi) { return cvt_pk_bf16(lo, hi); }

__device__ __forceinline__ void mask_tile(f32x16& p0, f32x16& p1, int dq) {
    const float NEG = -__builtin_inff();
#pragma unroll
    for (int r = 0; r < 16; ++r) { const int c = (r & 3) + 8 * (r >> 2);
        if ((unsigned)(dq - c + 64) > 128u) p0[r] = NEG;
        if ((unsigned)(dq - c - 32 + 64) > 128u) p1[r] = NEG; }
}
__device__ __forceinline__ void partialSM(f32x16& p0, f32x16& p1, float& m_reg, float& mn, float& alpha, const float thr = THR) {
    constexpr float C = SCALE * 1.4426950408889634f;
    float pmax = p0[0];
#pragma unroll
    for (int r = 1; r < 16; ++r) pmax = fmaxf(pmax, p0[r]);
#pragma unroll
    for (int r = 0; r < 16; ++r) pmax = fmaxf(pmax, p1[r]);
    { auto rr = __builtin_amdgcn_permlane32_swap(__float_as_uint(pmax), __float_as_uint(pmax), false, false);
      pmax = fmaxf(__uint_as_float(rr[0]), __uint_as_float(rr[1])); }
    if (__builtin_expect(__all(pmax - m_reg <= thr / SCALE), 1)) { mn = m_reg; alpha = 1.f; }
    else { mn = fmaxf(m_reg, pmax); alpha = __builtin_amdgcn_exp2f((m_reg - mn) * C); m_reg = mn; }
    const float mnC = -mn * C;
#pragma unroll
    for (int r = 0; r < 16; ++r) p0[r] = fmaf(p0[r], C, mnC);
#pragma unroll
    for (int r = 0; r < 16; ++r) p1[r] = fmaf(p1[r], C, mnC);
#pragma unroll
    for (int r = 0; r < 16; ++r) p0[r] = __builtin_amdgcn_exp2f(p0[r]);
}
__device__ __forceinline__ void finishSM(f32x16& p0, f32x16& p1, float alpha, float& l_reg, bf16x8& pa0, bf16x8& pa1, bf16x8& pa2, bf16x8& pa3) {
#pragma unroll
    for (int r = 0; r < 16; ++r) p1[r] = __builtin_amdgcn_exp2f(p1[r]);
    float ps = 0;
#pragma unroll
    for (int r = 0; r < 16; ++r) ps += p0[r];
#pragma unroll
    for (int r = 0; r < 16; ++r) ps += p1[r];
    { auto rr = __builtin_amdgcn_permlane32_swap(__float_as_uint(ps), __float_as_uint(ps), false, false);
      ps = __uint_as_float(rr[0]) + __uint_as_float(rr[1]); }
    l_reg = l_reg * alpha + ps;
#define PK4(P, BASE, OUT) do { unsigned a0 = cvtpk(P[BASE + 0], P[BASE + 1]), a1 = cvtpk(P[BASE + 2], P[BASE + 3]);   \
    unsigned b0 = cvtpk(P[BASE + 4], P[BASE + 5]), b1 = cvtpk(P[BASE + 6], P[BASE + 7]);                              \
    auto r0 = __builtin_amdgcn_permlane32_swap(a0, b0, false, false); auto r1 = __builtin_amdgcn_permlane32_swap(a1, b1, false, false); \
    u32x4 w = {r0[0], r1[0], r0[1], r1[1]}; OUT = *reinterpret_cast<bf16x8*>(&w); } while (0)
    PK4(p0, 0, pa0); PK4(p0, 8, pa1); PK4(p1, 0, pa2); PK4(p1, 8, pa3);
#undef PK4
}
__device__ __forceinline__ void qkt(f32x16& p0, f32x16& p1, const bf16_t* Ks, const bf16x8* qr, int r32, int hi) {
    p0 = f32x16{}; p1 = f32x16{};
#pragma unroll
    for (int d0 = 0; d0 < 8; ++d0) { const int cb = (d0 * 16 + hi * 8) * 2;
        const bf16x8 b0 = *reinterpret_cast<const bf16x8*>((const char*)Ks + KSWZ(r32, cb));
        const bf16x8 b1 = *reinterpret_cast<const bf16x8*>((const char*)Ks + KSWZ(32 + r32, cb));
        p0 = __builtin_amdgcn_mfma_f32_32x32x16_bf16(b0, qr[d0], p0, 0, 0, 0);
        p1 = __builtin_amdgcn_mfma_f32_32x32x16_bf16(b1, qr[d0], p1, 0, 0, 0); }
}
#define KSWZ8(row, colB) ((row) * 128 + ((colB) ^ ((((row) >> 1) & 7) << 4)))
typedef int v8i32a __attribute__((ext_vector_type(8)));
template <int DUMMY = 0>
__device__ __forceinline__ void qkt8(f32x16& p0, f32x16& p1, const char* Ks, const v8i32a (&q8)[2], int r32, int hi) {
    const int one_scale = 0x7f7f7f7f;
#pragma unroll
    for (int j = 0; j < 2; ++j) { const int cb = 64 * j + 32 * hi;
        const u32x4 a0l = *reinterpret_cast<const u32x4*>(Ks + KSWZ8(r32, cb)), a0h = *reinterpret_cast<const u32x4*>(Ks + KSWZ8(r32, cb + 16));
        const u32x4 a1l = *reinterpret_cast<const u32x4*>(Ks + KSWZ8(32 + r32, cb)), a1h = *reinterpret_cast<const u32x4*>(Ks + KSWZ8(32 + r32, cb + 16));
        const v8i32a a0 = {(int)a0l.x, (int)a0l.y, (int)a0l.z, (int)a0l.w, (int)a0h.x, (int)a0h.y, (int)a0h.z, (int)a0h.w};
        const v8i32a a1 = {(int)a1l.x, (int)a1l.y, (int)a1l.z, (int)a1l.w, (int)a1h.x, (int)a1h.y, (int)a1h.z, (int)a1h.w};
        if (j == 0) {
            asm volatile("v_mfma_scale_f32_32x32x64_f8f6f4 %0, %1, %2, 0, %3, %3 op_sel_hi:[0,0,0]" : "=&v"(p0) : "v"(a0), "v"(q8[j]), "v"(one_scale));
            asm volatile("v_mfma_scale_f32_32x32x64_f8f6f4 %0, %1, %2, 0, %3, %3 op_sel_hi:[0,0,0]" : "=&v"(p1) : "v"(a1), "v"(q8[j]), "v"(one_scale)); }
        else {
            asm volatile("v_mfma_scale_f32_32x32x64_f8f6f4 %0, %1, %2, %0, %3, %3 op_sel_hi:[0,0,0]" : "+v"(p0) : "v"(a0), "v"(q8[j]), "v"(one_scale));
            asm volatile("v_mfma_scale_f32_32x32x64_f8f6f4 %0, %1, %2, %0, %3, %3 op_sel_hi:[0,0,0]" : "+v"(p1) : "v"(a1), "v"(q8[j]), "v"(one_scale)); } }
    asm volatile("s_nop 15\n\ts_nop 15" : "+v"(p0), "+v"(p1));
}
constexpr float THR8 = 6.f;
#define VSWZ(d, colB) ((d) * 64 + ((colB) ^ ((((d) >> 2) & 3) << 4)))
__device__ __forceinline__ unsigned f4_to_fp8(float a, float b, float c, float d) { unsigned r = 0; r = __builtin_amdgcn_cvt_pk_fp8_f32(a, b, r, false); r = __builtin_amdgcn_cvt_pk_fp8_f32(c, d, r, true); return r; }
__device__ __forceinline__ void finishSM8(f32x16& p0, f32x16& p1, float alpha, float& l_reg, v8i32a& P8) {
#pragma unroll
    for (int r = 0; r < 16; ++r) p1[r] = __builtin_amdgcn_exp2f(p1[r]);
    float ps = 0;
#pragma unroll
    for (int r = 0; r < 16; ++r) ps += p0[r];
#pragma unroll
    for (int r = 0; r < 16; ++r) ps += p1[r];
    { auto rr = __builtin_amdgcn_permlane32_swap(__float_as_uint(ps), __float_as_uint(ps), false, false);
      ps = __uint_as_float(rr[0]) + __uint_as_float(rr[1]); }
    l_reg = l_reg * alpha + ps;
    P8 = (v8i32a){(int)f4_to_fp8(p0[0], p0[1], p0[2], p0[3]), (int)f4_to_fp8(p0[4], p0[5], p0[6], p0[7]), (int)f4_to_fp8(p0[8], p0[9], p0[10], p0[11]), (int)f4_to_fp8(p0[12], p0[13], p0[14], p0[15]),
                  (int)f4_to_fp8(p1[0], p1[1], p1[2], p1[3]), (int)f4_to_fp8(p1[4], p1[5], p1[6], p1[7]), (int)f4_to_fp8(p1[8], p1[9], p1[10], p1[11]), (int)f4_to_fp8(p1[12], p1[13], p1[14], p1[15])};
}
template <int DUMMY = 0>
__device__ __forceinline__ void pv8(f32x16* o, const char* Vl, const v8i32a& P8, int r32, int hi) {
    const int one_scale = 0x7f7f7f7f;
    v8i32a b[4];
#pragma unroll
    for (int d0 = 0; d0 < 4; ++d0) { const int d = 32 * d0 + r32;
        const u32x4 lo = *reinterpret_cast<const u32x4*>(Vl + VSWZ(d, 32 * hi)), hh = *reinterpret_cast<const u32x4*>(Vl + VSWZ(d, 32 * hi + 16));
        b[d0] = (v8i32a){(int)lo.x, (int)lo.y, (int)lo.z, (int)lo.w, (int)hh.x, (int)hh.y, (int)hh.z, (int)hh.w}; }
#pragma unroll
    for (int d0 = 0; d0 < 4; ++d0)
        asm volatile("v_mfma_scale_f32_32x32x64_f8f6f4 %0, %1, %2, %0, %3, %3 op_sel_hi:[0,0,0]" : "+v"(o[d0]) : "v"(P8), "v"(b[d0]), "v"(one_scale));
    asm volatile("s_nop 15\n\ts_nop 15" : "+v"(o[0]), "+v"(o[1]), "+v"(o[2]), "+v"(o[3]));
}
__device__ __forceinline__ unsigned bf8x4_to_fp8(unsigned w0, unsigned w1) {
    unsigned r = 0; r = __builtin_amdgcn_cvt_pk_fp8_f32(bf_lo(w0), bf_hi(w0), r, false); r = __builtin_amdgcn_cvt_pk_fp8_f32(bf_lo(w1), bf_hi(w1), r, true); return r; }
__device__ __forceinline__ int v_st(int k, int c) { const int kk = (k & ~0xC) | ((k & 4) << 1) | ((k & 8) >> 1); return ((kk >> 3) * 4 + (c >> 5)) * 512 + ((kk & 7) * 32 + (c & 31)) * 2; }
__device__ __forceinline__ int v_rd_base(int lane) { return ((lane & 3) << 3) | (((lane >> 2) & 3) << 6) | (((lane >> 4) & 1) << 5) | (((lane >> 5) & 1) << 8); }
constexpr int v_rd_off(int d0, int ks, int half) { return d0 * 512 + ks * 4096 + half * 2048; }
template <int OFF> __device__ __forceinline__ s16x4 tr_read(int vb) {
    s16x4 r; asm volatile("ds_read_b64_tr_b16 %0, %1 offset:%2" : "=&v"(r) : "v"(vb), "i"(OFF) : "memory"); return r;
}
template <int D0> __device__ __forceinline__ void pv_one(f32x16& od, int vb, bf16x8 pa0, bf16x8 pa1, bf16x8 pa2, bf16x8 pa3) {
    const s16x4 l0 = tr_read<v_rd_off(D0, 0, 0)>(vb), h0 = tr_read<v_rd_off(D0, 0, 1)>(vb), l1 = tr_read<v_rd_off(D0, 1, 0)>(vb), h1 = tr_read<v_rd_off(D0, 1, 1)>(vb);
    const s16x4 l2 = tr_read<v_rd_off(D0, 2, 0)>(vb), h2 = tr_read<v_rd_off(D0, 2, 1)>(vb), l3 = tr_read<v_rd_off(D0, 3, 0)>(vb), h3 = tr_read<v_rd_off(D0, 3, 1)>(vb);
    asm volatile("s_waitcnt lgkmcnt(0)" ::: "memory"); SBAR();
#define PK(L, H) (bf16x8){L[0], L[1], L[2], L[3], H[0], H[1], H[2], H[3]}
    od = __builtin_amdgcn_mfma_f32_32x32x16_bf16(pa0, PK(l0, h0), od, 0, 0, 0);
    od = __builtin_amdgcn_mfma_f32_32x32x16_bf16(pa1, PK(l1, h1), od, 0, 0, 0);
    od = __builtin_amdgcn_mfma_f32_32x32x16_bf16(pa2, PK(l2, h2), od, 0, 0, 0);
    od = __builtin_amdgcn_mfma_f32_32x32x16_bf16(pa3, PK(l3, h3), od, 0, 0, 0);
#undef PK
}
__device__ __forceinline__ void pv_d0(f32x16* o, int vb, bf16x8 pa0, bf16x8 pa1, bf16x8 pa2, bf16x8 pa3) {
    pv_one<0>(o[0], vb, pa0, pa1, pa2, pa3); pv_one<1>(o[1], vb, pa0, pa1, pa2, pa3); pv_one<2>(o[2], vb, pa0, pa1, pa2, pa3); pv_one<3>(o[3], vb, pa0, pa1, pa2, pa3);
}

template <bool BAND, int LDQ, int LDO, int LSE_STRIDE>
__device__ __forceinline__ void attn_unit(const bf16_t* __restrict__ Qb, const bf16_t* __restrict__ Kh, const bf16_t* __restrict__ Vh, bf16_t* __restrict__ Ob,
                                          int NT, int qoff, float* __restrict__ lse_out, char* lds, const int tid) {
    constexpr int ldq = LDQ, ldk = LDQ, ldo = LDO, lse_stride = LSE_STRIDE;
    const int wid = tid >> 6, lane = tid & 63, r32 = lane & 31, hi = lane >> 5;
    bf16_t* V_lds = (bf16_t*)lds; bf16_t* K_lds = (bf16_t*)(lds + 2 * SHM_V);
    float* ws = (float*)(lds + 2 * SHM_V + 2 * SHM_K) + wid * 64; float* li_l = ws; float* al_l = ws + 32;
    float m_reg = -1e30f, l_reg = 0; f32x16 o[4] = {}; v8i32a qr[2];
    { const bf16_t* Qw = Qb + (size_t)((wid * QBLK + r32) * ldq + hi * 32);
#pragma unroll
      for (int j = 0; j < 2; ++j) { u32x4 t[4];
#pragma unroll
          for (int q = 0; q < 4; ++q) t[q] = *reinterpret_cast<const u32x4*>(Qw + 64 * j + 8 * q);
          qr[j] = (v8i32a){(int)bf8x4_to_fp8(t[0].x, t[0].y), (int)bf8x4_to_fp8(t[0].z, t[0].w), (int)bf8x4_to_fp8(t[1].x, t[1].y), (int)bf8x4_to_fp8(t[1].z, t[1].w),
                           (int)bf8x4_to_fp8(t[2].x, t[2].y), (int)bf8x4_to_fp8(t[2].z, t[2].w), (int)bf8x4_to_fp8(t[3].x, t[3].y), (int)bf8x4_to_fp8(t[3].z, t[3].w)}; } }
    const int sr = tid >> 4, sc = (tid & 15) * 8, vst0 = v_st(sr, sc), vst1 = v_st(32 + sr, sc);
    const int vb0 = (int)(uintptr_t)V_lds + v_rd_base(lane);
    const int dq0 = qoff + wid * QBLK + r32 - 4 * hi;
    struct { u32x4 vs, ks; } sr_[2];
    const int kkey = tid >> 3, kch = (tid & 7) * 16;
    const int vd = tid >> 2, vkc = (tid & 3) * 16;
    const unsigned lo0 = (unsigned)(sr * ldk + sc) * 2u, lo1 = lo0 + (unsigned)(32 * ldk * 2);
#define SLOAD(i, k0) do { sr_[i].vs = *reinterpret_cast<const u32x4*>((const char*)Vh + (size_t)vd * SEQ + (k0) + vkc); \
    sr_[i].ks = *reinterpret_cast<const u32x4*>((const char*)Kh + (size_t)((k0) + kkey) * HD + kch); } while (0)
#define SWRITE(b, i) do { *(u32x2*)((char*)V_lds + (b) * SHM_V + VSWZ(vd, vkc / 2)) = (u32x2){sr_[i].vs.x, sr_[i].vs.z};          \
    *(u32x2*)((char*)V_lds + (b) * SHM_V + VSWZ(vd, 32 + vkc / 2)) = (u32x2){sr_[i].vs.y, sr_[i].vs.w};                                      \
    *(u32x4*)((char*)K_lds + (b) * SHM_K + KSWZ8(kkey, kch)) = sr_[i].ks; } while (0)
#define SWAIT() asm volatile("s_waitcnt vmcnt(2)" ::: "memory")
#define RESC(a) do { if (__any((a) < 1.f)) { if (hi == 0) al_l[r32] = (a); asm volatile("s_waitcnt lgkmcnt(0)" ::: "memory"); \
    _Pragma("unroll") for (int d = 0; d < 4; ++d) _Pragma("unroll") for (int r = 0; r < 16; ++r) o[d][r] *= al_l[crow(r, hi)]; } } while (0)
    f32x16 pA0, pA1, pB0, pB1; float mnA, mnB, alA, alB; v8i32a P8;
    constexpr int SE = 0, SO = 1;
    SLOAD(SE, 0); asm volatile("s_waitcnt vmcnt(0)" ::: "memory"); SWRITE(0, SE); __syncthreads();
    qkt8(pA0, pA1, (const char*)K_lds, qr, r32, hi); if (BAND) mask_tile(pA0, pA1, dq0); partialSM(pA0, pA1, m_reg, mnA, alA, THR8);
    SLOAD(SO, KVBLK); if (2 < NT) SLOAD(SE, 2 * KVBLK);
    SWAIT(); SWRITE(1, SO); __syncthreads();
    for (int j = 1; j + 1 < NT; j += 2) {
        SBAR(); qkt8(pB0, pB1, (const char*)K_lds + SHM_K, qr, r32, hi);
        finishSM8(pA0, pA1, alA, l_reg, P8); SBAR();
        SLOAD(SO, (j + 2) * KVBLK); SBAR();
        pv8(o, (const char*)V_lds, P8, r32, hi); if (BAND) mask_tile(pB0, pB1, dq0 - 64 * j); partialSM(pB0, pB1, m_reg, mnB, alB, THR8);
        __syncthreads(); SWAIT(); SWRITE(0, SE);
        RESC(alB); __syncthreads();
        SBAR(); qkt8(pA0, pA1, (const char*)K_lds, qr, r32, hi);
        finishSM8(pB0, pB1, alB, l_reg, P8); SBAR();
        if (j + 3 < NT) SLOAD(SE, (j + 3) * KVBLK); SBAR();
        pv8(o, (const char*)V_lds + SHM_V, P8, r32, hi); if (BAND) mask_tile(pA0, pA1, dq0 - 64 * (j + 1)); partialSM(pA0, pA1, m_reg, mnA, alA, THR8);
        __syncthreads(); SWAIT(); SWRITE(1, SO);
        RESC(alA); __syncthreads();
    }
    SBAR(); qkt8(pB0, pB1, (const char*)K_lds + SHM_K, qr, r32, hi);
    finishSM8(pA0, pA1, alA, l_reg, P8); SBAR();
    pv8(o, (const char*)V_lds, P8, r32, hi); if (BAND) mask_tile(pB0, pB1, dq0 - 64 * (NT - 1)); partialSM(pB0, pB1, m_reg, mnB, alB, THR8);
    __syncthreads(); RESC(alB);
    finishSM8(pB0, pB1, alB, l_reg, P8); SBAR();
    pv8(o, (const char*)V_lds + SHM_V, P8, r32, hi);
    if (hi == 0) li_l[r32] = l_reg; asm volatile("s_waitcnt lgkmcnt(0)" ::: "memory");
    if (BAND) { if (hi == 0) lse_out[(wid * QBLK + r32) * lse_stride] = m_reg * SCALE + __logf(l_reg); }
    float rli[16];
#pragma unroll
    for (int r = 0; r < 16; ++r) rli[r] = __builtin_amdgcn_rcpf(li_l[crow(r, hi)]);
    int tide = tid; asm volatile("" : "+v"(tide));
    const int r32e = tide & 31, hie = (tide >> 5) & 1, wide = tide >> 6;
    if (BAND) { bf16_t* Ow = Ob + (size_t)(unsigned)((wide * QBLK + 4 * hie) * ldo + r32e);
#pragma unroll
        for (int r = 0; r < 16; ++r) { const int orow = (r & 3) + 8 * (r >> 2);
#pragma unroll
            for (int d0 = 0; d0 < 4; ++d0) Ow[orow * ldo + d0 * 32] = (bf16_t)f2bf(o[d0][r] * rli[r]); } }
    else {
        unsigned char* Ow = (unsigned char*)Ob + (size_t)(unsigned)((wide * QBLK + 4 * hie) * ldo + r32e);
#pragma unroll
        for (int r = 0; r < 16; ++r) { const int orow = (r & 3) + 8 * (r >> 2); const float sc = rli[r] * AB_SCALE;
#pragma unroll
            for (int d0 = 0; d0 < 4; d0 += 2) { const unsigned w = __builtin_amdgcn_cvt_pk_fp8_f32(__builtin_amdgcn_fmed3f(o[d0][r] * sc, -448.f, 448.f), __builtin_amdgcn_fmed3f(o[d0 + 1][r] * sc, -448.f, 448.f), 0u, false);
                Ow[orow * ldo + d0 * 32] = (unsigned char)(w & 0xffu); Ow[orow * ldo + d0 * 32 + 32] = (unsigned char)((w >> 8) & 0xffu); } } }
#undef SLOAD
#undef SWRITE
#undef SWAIT
#undef RESC
}

template <int LDQ, int LDO, int LSE_STRIDE>
__device__ __forceinline__ void band_unit(const bf16_t* __restrict__ Qb, const bf16_t* __restrict__ Kh, const bf16_t* __restrict__ Vh, bf16_t* __restrict__ Ob,
                                          int NT, int qoff, float* __restrict__ lse_out, char* lds, const int tid) {
    constexpr int ldq = LDQ, ldk = LDQ, ldo = LDO;
    const int wid = tid >> 6, lane = tid & 63, r32 = lane & 31, hi = lane >> 5;
    bf16_t* V_lds = (bf16_t*)lds; bf16_t* K_lds = (bf16_t*)(lds + 2 * SHM_V);
    float* ws = (float*)(lds + 2 * SHM_V + 2 * SHM_K) + wid * 64; float* li_l = ws; float* al_l = ws + 32;
    float m_reg = -1e30f, l_reg = 0; f32x16 o[4] = {}; bf16x8 qr[8];
    const bf16_t* Qw = Qb + (size_t)((wid * QBLK + r32) * ldq + hi * 8);
#pragma unroll
    for (int d0 = 0; d0 < 8; ++d0) qr[d0] = *reinterpret_cast<const bf16x8*>(Qw + d0 * 16);
    const int sr = tid >> 4, sc = (tid & 15) * 8, vst0 = v_st(sr, sc), vst1 = v_st(32 + sr, sc);
    const int vb0 = (int)(uintptr_t)V_lds + v_rd_base(lane);
    const int qw = qoff + wid * QBLK, dq0 = qw + r32 - 4 * hi;
    const unsigned lo0 = (unsigned)(sr * ldk + sc) * 2u, lo1 = lo0 + (unsigned)(32 * ldk * 2);
    bf16x8 vs0, vs1, ks0, ks1;
#define BLOAD(k0) do { const char* vb_ = (const char*)Vh + (size_t)(k0) * (ldk * 2); const char* kb_ = (const char*)Kh + (size_t)(k0) * (ldk * 2); \
    vs0 = *reinterpret_cast<const bf16x8*>(vb_ + lo0); vs1 = *reinterpret_cast<const bf16x8*>(vb_ + lo1); \
    ks0 = *reinterpret_cast<const bf16x8*>(kb_ + lo0); ks1 = *reinterpret_cast<const bf16x8*>(kb_ + lo1); } while (0)
#define BWRITE(b) do { *(bf16x8*)((char*)V_lds + (b) * SHM_V + vst0) = vs0; *(bf16x8*)((char*)V_lds + (b) * SHM_V + vst1) = vs1; const int kc = sc * 2; \
    *(bf16x8*)((char*)K_lds + (b) * SHM_K + KSWZ(sr, kc)) = ks0; *(bf16x8*)((char*)K_lds + (b) * SHM_K + KSWZ(32 + sr, kc)) = ks1; } while (0)
    BLOAD(0); BWRITE(0); __syncthreads();
    for (int j = 0; j < NT; ++j) {
        const int buf = j & 1;
        if (j + 1 < NT) BLOAD((j + 1) * KVBLK);
        if (64 * j <= qw + 95 && 64 * j + 127 >= qw) {
            f32x16 p0, p1; float mn, al; bf16x8 pa0, pa1, pa2, pa3;
            qkt(p0, p1, (bf16_t*)((char*)K_lds + buf * SHM_K), qr, r32, hi);
            mask_tile(p0, p1, dq0 - 64 * j);
            partialSM(p0, p1, m_reg, mn, al);
            if (__any(al < 1.f)) { if (hi == 0) al_l[r32] = al; asm volatile("s_waitcnt lgkmcnt(0)" ::: "memory");
#pragma unroll
                for (int d = 0; d < 4; ++d)
#pragma unroll
                    for (int r = 0; r < 16; ++r) o[d][r] *= al_l[crow(r, hi)]; }
            finishSM(p0, p1, al, l_reg, pa0, pa1, pa2, pa3); SBAR();
            pv_d0(o, vb0 + buf * (int)SHM_V, pa0, pa1, pa2, pa3);
        }
        if (j + 1 < NT) BWRITE(buf ^ 1);
        __syncthreads();
    }
    if (hi == 0) li_l[r32] = l_reg; asm volatile("s_waitcnt lgkmcnt(0)" ::: "memory");
    if (hi == 0) lse_out[(wid * QBLK + r32) * LSE_STRIDE] = m_reg * SCALE + __logf(l_reg);
    float rli[16];
#pragma unroll
    for (int r = 0; r < 16; ++r) rli[r] = __builtin_amdgcn_rcpf(li_l[crow(r, hi)]);
    bf16_t* Ow = Ob + (size_t)(wid * QBLK * ldo);
#pragma unroll
    for (int r = 0; r < 16; ++r) { const int orow = crow(r, hi);
#pragma unroll
        for (int d0 = 0; d0 < 4; ++d0) Ow[orow * ldo + d0 * 32 + r32] = (bf16_t)f2bf(o[d0][r] * rli[r]); }
    __syncthreads();
#undef BLOAD
#undef BWRITE
}
}

constexpr size_t MiB = 1u << 20;
constexpr size_t WS_CTL = 0, CTL_ZERO_BYTES = 1 * MiB;
constexpr size_t WS_MOD = 1 * MiB;
constexpr size_t WS_ROPEA = 1 * MiB + 512 * 1024;
constexpr size_t WS_ROPEB = 2 * MiB;
constexpr size_t WS_LSE = 2 * MiB + 512 * 1024;
constexpr size_t WS_TSEL = 3 * MiB;
constexpr size_t WS_TW = 3 * MiB + 256 * 1024;
constexpr size_t WS_CNTT = 3 * MiB + 512 * 1024;
constexpr size_t WS_TOK = 4 * MiB;
constexpr size_t WS_GATE = 6 * MiB;
constexpr size_t WS_WIN = 8 * MiB;
constexpr size_t WS_WAB = 54 * MiB;
constexpr size_t WS_WO = 64 * MiB;
constexpr size_t WS_W13 = 72 * MiB;
constexpr size_t WS_W2 = 332 * MiB;
constexpr size_t WS_H = 462 * MiB;
constexpr size_t WS_PROJ = 494 * MiB;
constexpr size_t WS_OA = 678 * MiB;
constexpr size_t WS_AB = 702 * MiB;
constexpr size_t WS_MERGED = 806 * MiB;
constexpr size_t WS_HID = 838 * MiB;
constexpr size_t WS_Y = 462 * MiB;
constexpr size_t WS_WRTH = 926 * MiB, WS_WRTL = 926 * MiB + 512 * 1024;
constexpr size_t WS_RBIAS = 1 * MiB + 128 * 1024;
constexpr size_t WS_H8 = 927 * MiB;
constexpr size_t WS_WG8 = WS_WIN + (size_t)GATE_OFF * DM;
constexpr size_t WS_VT8 = 943 * MiB;
constexpr size_t WS_K8 = 947 * MiB;
constexpr size_t WS_END = 951 * MiB;
static_assert(WS_Y + (size_t)MOE_ROWS * DM * 2 <= WS_HID && WS_HID + (size_t)MOE_ROWS * DE * 2 <= WS_WRTH, "ws map");
constexpr int CW_MODRDY = 32;
constexpr int CW_COUNT = 64;
constexpr int CW_CQ = 128;
constexpr int CW_DONE = 160;
constexpr int CW_BAR = 4096;

constexpr int RING_BYTES = 131072;
constexpr int MISC_OFF = RING_BYTES;
constexpr int LDS_BYTES = 147456;
constexpr int MI_TP = 16, MI_CNT = 96, MI_BC = 4;
constexpr int XS_OFF = MISC_OFF + 4096;

#define XB_TMO      128
#define XB_XCNT(j)  (256  + 64 * (j))
#define XB_XSUB(j)  (1280 + 64 * (j))
#define XB_XGEN(j)  (2304 + 64 * (j))
#define XB_TOP      3328
#define XB_TOPGEN   3392
#define XCD_BAR_WORDS 3456
#define XB_SPIN_CAP (1u << 18)
__device__ __forceinline__ unsigned xb_ld(unsigned* p)              { return __hip_atomic_load(p, __ATOMIC_RELAXED, __HIP_MEMORY_SCOPE_AGENT); }
__device__ __forceinline__ unsigned xb_add(unsigned* p, unsigned v) { return __hip_atomic_fetch_add(p, v, __ATOMIC_RELAXED, __HIP_MEMORY_SCOPE_AGENT); }
__device__ __forceinline__ unsigned xb_xcc_id() { return (unsigned)__builtin_amdgcn_s_getreg((3 << 11) | 20) & 0xFu; }
#define XB_SPIN(cond, bar) do { unsigned _sp = 0; while (cond) { __builtin_amdgcn_s_sleep(1); \
    if ((++_sp & 255u) == 0u) { if (xb_ld(&(bar)[XB_TMO])) break; if (_sp > XB_SPIN_CAP) { atomicAdd(&(bar)[XB_TMO], 1u); break; } } } } while (0)
struct XcdBarrier { unsigned* bar; unsigned x; volatile LAS unsigned* st; };
__device__ __forceinline__ XcdBarrier xcd_barrier_post(unsigned* bar, volatile LAS unsigned* st, const bool leader) {
    XcdBarrier b; b.bar = bar; b.x = xb_xcc_id(); b.st = st;
    if (leader) (void)xb_add(&bar[XB_XCNT(b.x)], 1u);
    return b;
}
__device__ __forceinline__ void xcd_barrier_complete(unsigned* bar, unsigned x, unsigned& nloc, unsigned& nx) {
    const unsigned G = gridDim.x * gridDim.y * gridDim.z;
    unsigned sum, cnt, mine, sp = 0u;
    for (;;) {
        sum = 0u; cnt = 0u; mine = 0u;
#pragma unroll
        for (unsigned j = 0; j < 16; ++j) { const unsigned c = xb_ld(&bar[XB_XCNT(j)]); sum += c; cnt += (c > 0u) ? 1u : 0u; mine = (j == x) ? c : mine; }
        if (sum == G) break;
        __builtin_amdgcn_s_sleep(1);
        if ((++sp & 255u) == 0u) { if (xb_ld(&bar[XB_TMO])) break; if (sp > XB_SPIN_CAP) { atomicAdd(&bar[XB_TMO], 1u); break; } }
    }
    nloc = mine > 0u ? mine : 1u; nx = cnt > 0u ? cnt : 1u;
}
__device__ __forceinline__ void xcd_barrier(const XcdBarrier& b, const bool leader) {
    asm volatile("s_waitcnt vmcnt(0)" ::: "memory");
    __syncthreads();
    if (leader) {
        unsigned* bar = b.bar;
        __builtin_amdgcn_s_waitcnt(0);
        unsigned nloc = b.st[0], nx = b.st[1];
        if (nloc == 0u) { xcd_barrier_complete(bar, b.x, nloc, nx); b.st[0] = nloc; b.st[1] = nx; }
        const unsigned old = xb_add(&bar[XB_XSUB(b.x)], 1u);
        const unsigned gen = old / nloc;
        if (old + 1u == (gen + 1u) * nloc) {
            __builtin_amdgcn_fence(__ATOMIC_RELEASE, "agent");
            asm volatile("s_waitcnt vmcnt(0)" ::: "memory");
            const unsigned og = xb_add(&bar[XB_TOP], 1u);
            const unsigned tg = og / nx;
            if (og + 1u == (tg + 1u) * nx) xb_add(&bar[XB_TOPGEN], 1u);
            else XB_SPIN(xb_ld(&bar[XB_TOPGEN]) == tg, bar);
            __builtin_amdgcn_fence(__ATOMIC_ACQUIRE, "agent");
            xb_add(&bar[XB_XGEN(b.x)], 1u);
            asm volatile("s_waitcnt vmcnt(0)" ::: "memory");
        } else {
            XB_SPIN(xb_ld(&bar[XB_XGEN(b.x)]) == gen, bar);
            __builtin_amdgcn_fence(__ATOMIC_ACQUIRE, "agent");
            asm volatile("s_waitcnt vmcnt(0)" ::: "memory");
        }
    }
    __syncthreads();
}

constexpr int NWAVES = 8, NTHREADS = 512;
struct Args {
    const float *x, *c, *w_ada, *b_ada, *g_attn, *w_in, *b_gate, *q_norm_g, *k_norm_g, *w_a_up, *w_b_up, *w_out, *g_ffn, *w_router, *e_bias, *w1, *w3, *w2, *ws1, *ws3, *ws2, *g_final;
    float* out; unsigned char* ws; int ph_lo, ph_hi;
};
#define LDS_WAIT() asm volatile("s_waitcnt lgkmcnt(0)" ::: "memory")
__device__ __forceinline__ float wave_sum(float v) {
#define WS_SWZ(k) v += __uint_as_float((unsigned)__builtin_amdgcn_ds_swizzle((int)__float_as_uint(v), ((k) << 10) | 0x1f))
    WS_SWZ(1); WS_SWZ(2); WS_SWZ(4); WS_SWZ(8); WS_SWZ(16);
#undef WS_SWZ
    auto rr = __builtin_amdgcn_permlane32_swap(__float_as_uint(v), __float_as_uint(v), false, false);
    return __uint_as_float(rr[0]) + __uint_as_float(rr[1]);
}
template <int CTRL> __device__ __forceinline__ int dpp_i(int x) { return __builtin_amdgcn_update_dpp(0, x, CTRL, 0xf, 0xf, true); }
__device__ __forceinline__ float grp8_max(float x) {
    x = fmaxf(x, __builtin_bit_cast(float, dpp_i<0xB1>(__builtin_bit_cast(int, x)))); x = fmaxf(x, __builtin_bit_cast(float, dpp_i<0x4E>(__builtin_bit_cast(int, x))));
    return fmaxf(x, __builtin_bit_cast(float, dpp_i<0x141>(__builtin_bit_cast(int, x)))); }
__device__ __forceinline__ int grp8_min(int x) { x = min(x, dpp_i<0xB1>(x)); x = min(x, dpp_i<0x4E>(x)); return min(x, dpp_i<0x141>(x)); }
__device__ __forceinline__ float lane_bcast(float x, int l) { return __builtin_bit_cast(float, __builtin_amdgcn_readlane(__builtin_bit_cast(int, x), l)); }
__device__ const float ROPE_INV_A[16] = {1.000000000e+00f, 4.403665960e-01f, 1.939227432e-01f, 8.539710194e-02f, 3.760603070e-02f, 1.656044088e-02f, 7.292664610e-03f, 3.211446106e-03f,
    1.414213562e-03f, 6.227724371e-04f, 2.742481884e-04f, 1.207697351e-04f, 5.318295734e-05f, 2.341999971e-05f, 1.031338525e-05f, 4.541670478e-06f};
__device__ const float ROPE_INV_B[32] = {1.000000000e+00f, 7.498942018e-01f, 5.623413324e-01f, 4.216965139e-01f, 3.162277639e-01f, 2.371373773e-01f, 1.778279394e-01f, 1.333521456e-01f,
    1.000000015e-01f, 7.498942316e-02f, 5.623413250e-02f, 4.216964915e-02f, 3.162277490e-02f, 2.371373773e-02f, 1.778279431e-02f, 1.333521400e-02f, 9.999999776e-03f, 7.498942316e-03f,
    5.623413250e-03f, 4.216964822e-03f, 3.162277630e-03f, 2.371373819e-03f, 1.778279431e-03f, 1.333521446e-03f, 1.000000047e-03f, 7.498941850e-04f, 5.623413017e-04f, 4.216965172e-04f,
    3.162277571e-04f, 2.371373703e-04f, 1.778279402e-04f, 1.333521504e-04f};
__device__ __forceinline__ void cos_sin_reduced(float ang, float& c, float& s) {
    const float n = rintf(ang * 0.15915494309189535f);
    float r = fmaf(-n, 6.28125f, ang); r = fmaf(-n, 1.935307169333e-03f, r); r = fmaf(-n, 1.025313167702e-11f, r);
    c = cosf(r); s = sinf(r);
}

__device__ __forceinline__ int win_dest_row(int n) {
    if (n < A_COLS) { const int w = n % 1536, d = n & 127; if (w >= 1024 || d >= 32) return n; return (n & ~31) + 2 * (d & 15) + (d >> 4); }
    if (n < BV_OFF) { const int dd = n & 63; return (n & ~63) + 2 * (dd & 31) + (dd >> 5); }
    return n;
}
template <bool ROWMAP>
__device__ __forceinline__ void copy_item_bf16(const float* W, int ldn, int K, bf16_t* WT, int drow0, int k0, int n0, int lane) {
    const int r = lane >> 3, c4 = lane & 7;
    const float* p = W + (size_t)(k0 + 8 * r) * ldn + n0 + 4 * c4;
    f32x4 v[8];
#pragma unroll
    for (int i = 0; i < 8; ++i) v[i] = __builtin_nontemporal_load((const f32x4*)(p + (size_t)i * ldn));
#pragma unroll
    for (int j = 0; j < 4; ++j) {
        u32x4 o; o.x = cvt_pk_bf16(v[0][j], v[1][j]); o.y = cvt_pk_bf16(v[2][j], v[3][j]); o.z = cvt_pk_bf16(v[4][j], v[5][j]); o.w = cvt_pk_bf16(v[6][j], v[7][j]);
        const int row = ROWMAP ? win_dest_row(n0 + 4 * c4 + j) : drow0 + 4 * c4 + j;
        *(u32x4*)(WT + (size_t)row * K + k0 + 8 * r) = o; }
}
template <bool ROWMAP = false>
__device__ __forceinline__ void copy_item_fp8(const float* W, int ldn, int K, unsigned char* WT, int drow0, int k0, int n0, int lane, float sc) {
    const int r = lane >> 3, c4 = lane & 7;
    const float* p = W + (size_t)(k0 + 16 * r) * ldn + n0 + 4 * c4;
    f32x4 v[16];
#pragma unroll
    for (int i = 0; i < 16; ++i) v[i] = __builtin_nontemporal_load((const f32x4*)(p + (size_t)i * ldn));
#pragma unroll
    for (int j = 0; j < 4; ++j) {
        unsigned o[4];
#pragma unroll
        for (int q = 0; q < 4; ++q) { unsigned w = 0; w = __builtin_amdgcn_cvt_pk_fp8_f32(v[4 * q][j] * sc, v[4 * q + 1][j] * sc, w, false); w = __builtin_amdgcn_cvt_pk_fp8_f32(v[4 * q + 2][j] * sc, v[4 * q + 3][j] * sc, w, true); o[q] = w; }
        const int row = ROWMAP ? win_dest_row(n0 + 4 * c4 + j) : drow0 + 4 * c4 + j;
        __builtin_nontemporal_store((u32x4){o[0], o[1], o[2], o[3]}, (u32x4*)(WT + (size_t)row * K + k0 + 16 * r)); }
}

#define CQ_LOAD(v, off) _Pragma("unroll") for (int i = 0; i < 16; ++i) v[i] = __builtin_nontemporal_load((const f32x4*)(p + (size_t)i * ldn + (off)))
#define CQ_CVT(v, rowoff) _Pragma("unroll") for (int j = 0; j < 4; ++j) { unsigned o[4]; \
        _Pragma("unroll") for (int q = 0; q < 4; ++q) { unsigned w = 0; w = __builtin_amdgcn_cvt_pk_fp8_f32(v[4 * q][j] * sc, v[4 * q + 1][j] * sc, w, false); w = __builtin_amdgcn_cvt_pk_fp8_f32(v[4 * q + 2][j] * sc, v[4 * q + 3][j] * sc, w, true); o[q] = w; } \
        __builtin_nontemporal_store((u32x4){o[0], o[1], o[2], o[3]}, (u32x4*)(d + (size_t)((rowoff) + j) * K)); }

struct MoeSched1 {
    static constexpr bool GATHER = true;
    const char* A; const char* Bt; const unsigned* tok_of; LAS const int* tp; LAS const int* cnt; int G, c, lane;
    __device__ __forceinline__ bool next(int i, pg8::Unit& u) const {
        int L = i * G + c; if ((G & 255) == 0) { const int x = c & 7, j = (c & 255) >> 3; L = (i * (G >> 8) + (c >> 8)) * 256 + ((8 * x + (j >> 2)) << 2) + (j & 3); }
        const int total = tp[NEX] * 4; if (L >= total) return false;
        const int gm = L >> 2;
        const int e = __builtin_popcountll(__ballot(tp[lane + 1] <= gm));
        u.pm = gm; u.pn = L & 3; u.e = __builtin_amdgcn_readfirstlane(e); u.aux = (gm - tp[u.e]) * 256; return true;
    }
    __device__ __forceinline__ const char* a_tile(const pg8::Unit&) const { return A; }
    __device__ __forceinline__ const char* b_tile(const pg8::Unit& u) const { return Bt + (size_t)u.e * (1024 * DM) + (size_t)u.pn * (256 * DM); }
    __device__ __forceinline__ void a_voff(const pg8::Unit& u, const int (&R)[2], const int (&C)[2], unsigned (&v)[2][2]) const {
        const int ce = cnt[u.e];
#pragma unroll
        for (int h = 0; h < 2; ++h)
#pragma unroll
            for (int i = 0; i < 2; ++i) { const int slot = u.aux + 128 * h + R[i]; unsigned tok = (unsigned)slot;
                if (u.e < NE) tok = slot < ce ? tok_of[(size_t)u.e * ECAP + slot] : 0u;
                v[h][i] = tok * (unsigned)DM + (unsigned)C[i] * 2u; }
    }
};
struct MoeSched2 {
    static constexpr bool GATHER = false;
    const char* A; const char* Bt; LAS const int* tp; int G, c, lane;
    __device__ __forceinline__ bool next(int i, pg8::Unit& u) const {
        int L = i * G + c; if ((G & 255) == 0) { const int x = c & 7, j = (c & 255) >> 3; L = (i * (G >> 8) + (c >> 8)) * 256 + ((4 * x + (j >> 3)) << 3) + (j & 7); }
        const int total = tp[NEX] * 8; if (L >= total) return false;
        const int gm = L >> 3;
        const int e = __builtin_popcountll(__ballot(tp[lane + 1] <= gm));
        u.pm = gm; u.pn = L & 7; u.e = __builtin_amdgcn_readfirstlane(e); u.aux = 0; return true;
    }
    __device__ __forceinline__ const char* a_tile(const pg8::Unit& u) const { return A + (size_t)u.pm * (256 * DE); }
    __device__ __forceinline__ const char* b_tile(const pg8::Unit& u) const { return Bt + (size_t)u.e * (DM * DE) + (size_t)u.pn * (256 * DE); }
    __device__ __forceinline__ void a_voff(const pg8::Unit&, const int (&R)[2], const int (&C)[2], unsigned (&v)[2][2]) const {
#pragma unroll
        for (int h = 0; h < 2; ++h)
#pragma unroll
            for (int i = 0; i < 2; ++i) v[h][i] = (unsigned)((R[i] + 128 * h) * DE + C[i] * 2);
    }
};

constexpr int NPHASE = 13;
typedef const __attribute__((address_space(4))) Args ArgsK;
__device__ __forceinline__ ArgsK* args_ptr() { ArgsK* p = (ArgsK*)__builtin_amdgcn_kernarg_segment_ptr(); asm volatile("" : "+s"(p)); return p; }
#define PHASE_ARGS ArgsK& a = *args_ptr(); unsigned char* const ws = a.ws; (void)ws; int tid_ = threadIdx.x; asm volatile("" : "+v"(tid_)); __builtin_assume((unsigned)tid_ < 512u); const int tid = tid_, lane = tid & 63; (void)tid; (void)lane;
#define WSP(T, off) ((T*)(ws + (off)))
constexpr int NQ13 = 2 * NEX * 256, NQ2 = NEX * 256, NCH = (NQ13 + NQ2) / 32;
__device__ __forceinline__ void bg_fill(ArgsK& a, unsigned char* ws, volatile LAS unsigned* MISC, int slot, int G, int wave, int tid, int lane, int maxc = 1 << 30) {
    unsigned* cq = (unsigned*)(ws + WS_CTL) + CW_CQ; unsigned* dn = (unsigned*)(ws + WS_CTL) + CW_DONE + 32 * (slot < 0 ? 0 : slot);
    __syncthreads();
    if (tid == 0) { unsigned c0 = (unsigned)NCH; bool last = false;
        if (slot >= 0) last = __hip_atomic_fetch_add(dn, 1u, __ATOMIC_RELAXED, __HIP_MEMORY_SCOPE_AGENT) + 1u >= (unsigned)G;
        if (!last) c0 = __hip_atomic_fetch_add(cq, 1u, __ATOMIC_RELAXED, __HIP_MEMORY_SCOPE_AGENT);
        MISC[MI_BC] = c0; }
    __syncthreads();
    int zv = 0; asm volatile("" : "+v"(zv));
    int par = 0, left = maxc; unsigned c = (unsigned)__builtin_amdgcn_readfirstlane((int)MISC[MI_BC]);
    while (c < (unsigned)NCH) {
        --left;
        const int q = 32 * (int)c + 4 * wave;
        const float* src; unsigned char* dst; int ldn, K, drow, k0, n0; float sc;
        if (q < NQ13) { const int which = q / (NEX * 256), r = q - which * (NEX * 256), e = r >> 8, rr = r & 255; k0 = 128 * (rr >> 4); n0 = 32 * (rr & 15);
            src = (e < NE) ? ((which ? a.w3 : a.w1) + (size_t)e * DM * DE) : (which ? a.ws3 : a.ws1); ldn = DE; K = DM; dst = ws + WS_W13 + (size_t)e * 1024 * DM; drow = (n0 >> 7) * 256 + which * 128 + (n0 & 127); sc = W13_SCALE; }
        else { const int r = q - NQ13, e = r >> 8, rr = r & 255; k0 = 128 * (rr >> 6); n0 = 32 * (rr & 63);
            src = (e < NE) ? (a.w2 + (size_t)e * DE * DM) : a.ws2; ldn = DM; K = DE; dst = ws + WS_W2 + (size_t)e * DM * DE; drow = n0; sc = W2_SCALE; }
        const int r16 = lane >> 3, c4 = lane & 7;
        const float* p = src + (size_t)(k0 + 16 * r16) * ldn + n0 + 4 * c4; unsigned char* d = dst + (size_t)(drow + 4 * c4) * K + k0 + 16 * r16;
        unsigned dv = 0u, nx = (unsigned)NCH;
        if (tid == 0 && slot >= 0) dv = __hip_atomic_load(dn, __ATOMIC_RELAXED, __HIP_MEMORY_SCOPE_AGENT);
        f32x4 va[16], vb[16];
        CQ_LOAD(va, 0); CQ_LOAD(vb, 32);
        CQ_CVT(va, 0);
        if (tid == 0 && left > 0 && !(slot >= 0 && dv >= (unsigned)G)) nx = __hip_atomic_fetch_add(cq + zv, 1u, __ATOMIC_RELAXED, __HIP_MEMORY_SCOPE_AGENT);
        CQ_LOAD(va, 64); CQ_CVT(vb, 32); CQ_LOAD(vb, 96); CQ_CVT(va, 64); CQ_CVT(vb, 96);
        if (tid == 0) MISC[MI_BC + (par ^ 1)] = nx;
        asm volatile("s_waitcnt lgkmcnt(0)" ::: "memory"); __builtin_amdgcn_s_barrier();
        par ^= 1; c = (unsigned)__builtin_amdgcn_readfirstlane((int)MISC[MI_BC + par]);
    }
}

__global__ void __launch_bounds__(NTHREADS, 2) fwd_kernel(Args a_in) {
    extern __shared__ __attribute__((aligned(16))) unsigned char lds_raw[];
    LAS unsigned char* lds = (LAS unsigned char*)lds_raw;
    volatile LAS unsigned* MISC = (volatile LAS unsigned*)(lds + MISC_OFF);
    const int wave = __builtin_amdgcn_readfirstlane((int)(threadIdx.x >> 6));
    const int G = gridDim.x, bx = blockIdx.x;
    const int gw = bx * NWAVES + wave, NGW = G * NWAVES;
#define TID_LANE const int tid = threadIdx.x, lane = tid & 63; (void)tid; (void)lane;
    unsigned* ctl = (unsigned*)(a_in.ws + WS_CTL);
    { TID_LANE for (int u = tid; u < (LDS_BYTES - MISC_OFF) / 4; u += NTHREADS) MISC[u] = 0u; }
    __syncthreads();
    XcdBarrier bar; bar.bar = ctl + CW_BAR; bar.x = 0; bar.st = nullptr;
    if (MK_N_LAUNCHES == 1) bar = xcd_barrier_post(ctl + CW_BAR, MISC + 0, wave == 0 && lane_id() == 0);
    const int lo = a_in.ph_lo, hi = a_in.ph_hi;
#ifdef PHASE_MASK
#define IN(k) (((PHASE_MASK >> (k)) & 1) && lo <= (k) && (k) < hi)
#elif defined(ONLY_PHASE)
#define IN(k) ((k) == ONLY_PHASE && lo <= (k) && (k) < hi)
#else
#define IN(k) (lo <= (k) && (k) < hi)
#endif
#define SEAM(k) do { if (IN(k) && IN((k) + 1)) xcd_barrier(bar, wave == 0 && lane_id() == 0); } while (0)

    if (IN(0)) {
        PHASE_ARGS float* MOD = WSP(float, WS_MOD); float* ROPEA = WSP(float, WS_ROPEA); float* ROPEB = WSP(float, WS_ROPEB);
        unsigned char* WIN8 = WSP(unsigned char, WS_WIN); unsigned char* WAB8 = WSP(unsigned char, WS_WAB); unsigned char* WO8 = WSP(unsigned char, WS_WO);
        {
            LAS float* cs = (LAS float*)lds;
            LAS float* red = (LAS float*)(lds + 16384);
            for (int nb = bx; nb < (6 * DM) / 48; nb += G) {
                for (int i = tid; i < 2 * DM; i += NTHREADS) { const float v = a.c[i]; cs[i] = v / (1.0f + __expf(-v)); }
                __syncthreads();
                const int c4 = tid % 12, kk = tid / 12, n0 = nb * 48 + 4 * c4;
                if (kk < 42) {
                    f32x4 acc0 = {0.f, 0.f, 0.f, 0.f}, acc1 = {0.f, 0.f, 0.f, 0.f};
#pragma unroll 8
                    for (int k = kk; k < DM; k += 42) { const f32x4 w = __builtin_nontemporal_load((const f32x4*)(a.w_ada + (size_t)k * (6 * DM) + n0)); acc0 += w * cs[k]; acc1 += w * cs[DM + k]; }
                    *(LAS f32x4*)(red + (kk * 12 + c4) * 8) = acc0; *(LAS f32x4*)(red + (kk * 12 + c4) * 8 + 4) = acc1;
                }
                __syncthreads();
                if (tid < 96) { const int b = tid / 48, cc = tid % 48; float s = 0.f;
                    for (int k2 = 0; k2 < 42; ++k2) s += red[(k2 * 12 + (cc >> 2)) * 8 + b * 4 + (cc & 3)];
                    __hip_atomic_store(MOD + b * (6 * DM) + nb * 48 + cc, s + a.b_ada[nb * 48 + cc], __ATOMIC_RELAXED, __HIP_MEMORY_SCOPE_AGENT); }
                asm volatile("s_waitcnt vmcnt(0)" ::: "memory");
                __syncthreads();
                if (tid == 0) __hip_atomic_fetch_add(WSP(unsigned, WS_CTL) + CW_MODRDY, 1u, __ATOMIC_RELAXED, __HIP_MEMORY_SCOPE_AGENT);
            }
        }
        for (int i = bx * NTHREADS + tid; i < SEQ * 16; i += G * NTHREADS) { const int t = i >> 4, f = i & 15; float c, s; cos_sin_reduced((float)t * ROPE_INV_A[f], c, s); ROPEA[2 * i] = c; ROPEA[2 * i + 1] = s; }
        for (int i = bx * NTHREADS + tid; i < 64 * 32; i += G * NTHREADS) { const int p = i >> 5, f = i & 31; float c, s; cos_sin_reduced((float)p * ROPE_INV_B[f], c, s); ROPEB[2 * i] = c; ROPEB[2 * i + 1] = s; }
        {
            constexpr int I_IN = (DM / 128) * (GATE_OFF / 32), I_G = (DM / 128) * ((IN_COLS - GATE_OFF) / 32), I_A = (512 / 128) * (DM / 32), I_SQ = (DM / 128) * (DM / 32), I_O8 = (DM / 128) * (DM / 32);
            constexpr int NITEMS = I_IN + I_G + I_A + I_SQ + I_O8;
            for (int it = gw; it < NITEMS; it += NGW) {
                int r = it;
                if (r < I_IN) { const int nblk = GATE_OFF / 32, kb = r / nblk, nb = r % nblk; copy_item_fp8<true>(a.w_in, IN_COLS, DM, WIN8, 0, 128 * kb, 32 * nb, lane, WG_SCALE); continue; } r -= I_IN;
                if (r < I_G) { const int nblk = (IN_COLS - GATE_OFF) / 32, kb = r / nblk, nb = r % nblk; copy_item_fp8(a.w_in, IN_COLS, DM, WSP(unsigned char, WS_WG8), 32 * nb, 128 * kb, GATE_OFF + 32 * nb, lane, WG_SCALE); continue; } r -= I_G;
                if (r < I_A) { const int nblk = DM / 32, kb = r / nblk, nb = r % nblk; copy_item_fp8(a.w_a_up, DM, KAB, WAB8, 32 * nb, 128 * kb, 32 * nb, lane, WAB_SCALE); continue; } r -= I_A;
                if (r < I_SQ) { const int nblk = DM / 32, kb = r / nblk, nb = r % nblk; copy_item_fp8(a.w_b_up, DM, KAB, WAB8 + 512, 32 * nb, 128 * kb, 32 * nb, lane, WAB_SCALE); continue; } r -= I_SQ;
                { const int nblk = DM / 32, kb = r / nblk, nb = r % nblk; copy_item_fp8(a.w_out, DM, DM, WO8, 32 * nb, 128 * kb, 32 * nb, lane, WO_SCALE); }
            }
        }
        { bf16_t* H = WSP(bf16_t, WS_H);
          if (tid < 64) { unsigned sp = 0; while ((unsigned)__builtin_amdgcn_readfirstlane((int)__hip_atomic_load(WSP(unsigned, WS_CTL) + CW_MODRDY, __ATOMIC_RELAXED, __HIP_MEMORY_SCOPE_AGENT)) < (unsigned)((6 * DM) / 48)) { __builtin_amdgcn_s_sleep(2); if (++sp > (1u << 22)) break; }
              __builtin_amdgcn_fence(__ATOMIC_ACQUIRE, "agent"); asm volatile("s_waitcnt vmcnt(0)" ::: "memory"); }
          __syncthreads();
          { bf16_t* WRTH = WSP(bf16_t, WS_WRTH); bf16_t* WRTL = WSP(bf16_t, WS_WRTL); float* RB = WSP(float, WS_RBIAS);
            for (int i = bx * NTHREADS + tid; i < 2 * DM * NE; i += G * NTHREADS) { const int k = i % DM, e = (i / DM) % NE, b = i / (DM * NE);
                const float w = a.w_router[k * NE + e] * (a.g_ffn[k] * (MOD[b * (6 * DM) + 4 * DM + k] + 1.0f)); const unsigned hb = f2bf(w); const float hf = __uint_as_float(hb << 16);
                WRTH[i] = (bf16_t)hb; WRTL[i] = (bf16_t)f2bf(w - hf); }
            for (int j = gw; j < 2 * NE; j += NGW) { const int b = j >> 6, e = j & 63; float sb = 0.f;
#pragma unroll 8
                for (int k = lane; k < DM; k += 64) sb += MOD[b * (6 * DM) + 3 * DM + k] * a.w_router[k * NE + e];
                sb = wave_sum(sb); if (lane == 0) RB[j] = sb; } }
        for (int m = gw; m < MTOK; m += NGW) {
            const int b = m / SEQ; const float* mod = MOD + b * (6 * DM);
            const f32x4* xr = (const f32x4*)(a.x + (size_t)m * DM) + lane;
            f32x4 v[8]; float s = 0.f;
#pragma unroll
            for (int j = 0; j < 8; ++j) { v[j] = xr[64 * j]; s += (v[j].x * v[j].x + v[j].y * v[j].y) + (v[j].z * v[j].z + v[j].w * v[j].w); }
            const float rstd = 1.0f / sqrtf(wave_sum(s) * (1.f / DM) + EPS);
            unsigned* o4 = (unsigned*)(WSP(unsigned char, WS_H8) + (size_t)m * DM) + lane;
#pragma unroll
            for (int j = 0; j < 8; ++j) { const int col = 4 * lane + 256 * j;
                const f32x4 g = *(const f32x4*)(a.g_attn + col), sh = *(const f32x4*)(mod + col), sc = *(const f32x4*)(mod + DM + col);
                const f32x4 y = v[j] * rstd * g * (sc + 1.0f) + sh;
                unsigned w8 = 0; w8 = __builtin_amdgcn_cvt_pk_fp8_f32(y.x, y.y, w8, false); w8 = __builtin_amdgcn_cvt_pk_fp8_f32(y.z, y.w, w8, true); o4[64 * j] = w8; }
        }
        }
    }
    SEAM(1);
    if (IN(2)) {
        PHASE_ARGS const unsigned char* H8 = WSP(unsigned char, WS_H8); const unsigned char* WIN8 = WSP(unsigned char, WS_WIN); bf16_t* PROJ = WSP(bf16_t, WS_PROJ); const float* ROPEA = WSP(float, WS_ROPEA); const float* ROPEB = WSP(float, WS_ROPEB);
        pg8::DenseSched8 S; S.A = (const char*)H8; S.Bt = (const char*)WIN8; S.K = DM; S.o.init(MTOK, IN_COLS, G, bx);
        pg8::EpiProj E{PROJ, a.b_gate, ROPEA, ROPEB, a.q_norm_g, a.k_norm_g, (LAS float*)(lds + XS_OFF), WSP(unsigned char, WS_VT8), WSP(unsigned char, WS_K8)};
        pg8::gemm_phase<pg8::EpiProj, pg8::DenseSched8, true, true>(lds, DM, S, E, tid);
        bg_fill(a, ws, MISC, 0, G, wave, tid, lane);
    }
    SEAM(3);
    if (IN(4)) {
        PHASE_ARGS const bf16_t* PROJ = WSP(bf16_t, WS_PROJ); bf16_t* OA = WSP(bf16_t, WS_OA); unsigned char* AB8 = WSP(unsigned char, WS_AB); float* LSE = WSP(float, WS_LSE);
        char* alds = (char*)lds_raw;
#ifndef NO_ATT_B
        int it = 0;
#pragma unroll 1
        for (int u = bx; u < 512; u += G, ++it) {
            if (FORCE_NF > 0 && it == (bx & 3)) bg_fill(a, ws, MISC, -1, G, wave, tid, lane, FORCE_NF);
            const int b = u >> 8, c = u & 255, xcd = c & 7, j = c >> 3, kvh = xcd >> 1, local = (xcd & 1) * 32 + j, hq = kvh * 4 + (local >> 4), qb = local & 15;
            const bf16_t* base = PROJ + (size_t)(b * SEQ) * IN_COLS;
            att::attn_unit<false, IN_COLS, KAB, 0>(base + (size_t)(qb * 256) * IN_COLS + BQ_OFF + hq * HD, (const bf16_t*)(WSP(unsigned char, WS_K8) + (size_t)((b * 4 + kvh) * SEQ) * HD), (const bf16_t*)(WSP(unsigned char, WS_VT8) + (size_t)((b * 4 + kvh) * HD) * SEQ),
                                  (bf16_t*)(AB8 + (size_t)(b * SEQ + qb * 256) * KAB + 512 + hq * HD), SEQ / 64, 0, nullptr, alds, tid);
        }
#endif
    }
    if (IN(4)) {
        PHASE_ARGS const bf16_t* PROJ = WSP(bf16_t, WS_PROJ); bf16_t* OA = WSP(bf16_t, WS_OA); float* LSE = WSP(float, WS_LSE);
        char* alds = (char*)lds_raw;
#ifndef NO_ATT_A
#pragma unroll 1
        for (int st = 2; st < 4; ++st) {
        if (FORCE_NF > 0 && st == (bx & 3)) bg_fill(a, ws, MISC, -1, G, wave, tid, lane, FORCE_NF);
        if (st == 2)
#pragma unroll 1
        for (int u = bx; u < 384; u += G) {
            const int sub = u & 15, h = (u >> 4) & 3, g = (u >> 6) % 3, b = u / 192;
            const int dil = (g == 0) ? 1 : (g == 1 ? 4 : 16), L = SEQ / dil, nqb = L / 256;
            const int res = sub / nqb, qb = sub % nqb, q0 = qb * 256;
            const int NT = (L / 64) < 6 ? (L / 64) : 6;
            int klo = q0 - 64; if (klo < 0) klo = 0; if (klo > L - 64 * NT) klo = L - 64 * NT;
            const bf16_t* base = PROJ + (size_t)(b * SEQ + res) * IN_COLS + g * 1536 + h * HD;
            const long ld = (long)dil * IN_COLS;
            bf16_t* op = OA + (size_t)g * MTOK * 512 + (size_t)(b * SEQ + res + q0 * dil) * 512 + h * HD;
            float* lp = LSE + (size_t)g * MTOK * 4 + (size_t)(b * SEQ + res + q0 * dil) * 4 + h;
            if (g == 0)      att::band_unit<IN_COLS, 512, 4>(base + (size_t)q0 * ld, base + 512 + (size_t)klo * ld, base + 1024 + (size_t)klo * ld, op, NT, q0 - klo, lp, alds, tid);
            else if (g == 1) att::band_unit<4 * IN_COLS, 4 * 512, 16>(base + (size_t)q0 * ld, base + 512 + (size_t)klo * ld, base + 1024 + (size_t)klo * ld, op, NT, q0 - klo, lp, alds, tid);
            else             att::band_unit<16 * IN_COLS, 16 * 512, 64>(base + (size_t)q0 * ld, base + 512 + (size_t)klo * ld, base + 1024 + (size_t)klo * ld, op, NT, q0 - klo, lp, alds, tid);
        }
        }
#endif
        bg_fill(a, ws, MISC, 1, G, wave, tid, lane);
    }
    SEAM(4);
    if (IN(5)) {
        PHASE_ARGS const bf16_t* OA = WSP(bf16_t, WS_OA); const float* LSE = WSP(float, WS_LSE); unsigned char* AB8 = WSP(unsigned char, WS_AB);
        for (int m = gw; m < MTOK; m += NGW) {
            const int h = lane >> 4;
            const float l0 = LSE[(size_t)m * 4 + h], l1 = LSE[(size_t)(MTOK + m) * 4 + h], l2 = LSE[(size_t)(2 * MTOK + m) * 4 + h];
            const float mx = fmaxf(l0, fmaxf(l1, l2)); const float e0 = __expf(l0 - mx), e1 = __expf(l1 - mx), e2 = __expf(l2 - mx); const float inv = 1.0f / (e0 + e1 + e2);
            f32x4 a0, a1, b0, b1, c0, c1;
            unpack8(*(const u32x4*)(OA + (size_t)m * 512 + 8 * lane), a0, a1);
            unpack8(*(const u32x4*)(OA + (size_t)(MTOK + m) * 512 + 8 * lane), b0, b1);
            unpack8(*(const u32x4*)(OA + (size_t)(2 * MTOK + m) * 512 + 8 * lane), c0, c1);
            const float w0 = e0 * inv, w1 = e1 * inv, w2 = e2 * inv;
            f32x4 v0 = (a0 * w0 + b0 * w1 + c0 * w2) * AB_SCALE, v1 = (a1 * w0 + b1 * w1 + c1 * w2) * AB_SCALE; unsigned lo = 0, hi = 0;
#pragma unroll
            for (int j = 0; j < 4; ++j) { v0[j] = __builtin_amdgcn_fmed3f(v0[j], -448.f, 448.f); v1[j] = __builtin_amdgcn_fmed3f(v1[j], -448.f, 448.f); }
            lo = __builtin_amdgcn_cvt_pk_fp8_f32(v0[0], v0[1], lo, false); lo = __builtin_amdgcn_cvt_pk_fp8_f32(v0[2], v0[3], lo, true);
            hi = __builtin_amdgcn_cvt_pk_fp8_f32(v1[0], v1[1], hi, false); hi = __builtin_amdgcn_cvt_pk_fp8_f32(v1[2], v1[3], hi, true);
            *(u32x2*)(AB8 + (size_t)m * KAB + 8 * lane) = (u32x2){lo, hi};
        }
    }
    SEAM(5);
    if (IN(6)) {
        PHASE_ARGS const unsigned char* AB8 = WSP(unsigned char, WS_AB); const unsigned char* WAB8 = WSP(unsigned char, WS_WAB); const bf16_t* PROJ = WSP(bf16_t, WS_PROJ); unsigned char* MERGED = WSP(unsigned char, WS_MERGED);
        pg8::DenseSched8 S; S.A = (const char*)AB8; S.Bt = (const char*)WAB8; S.K = KAB; S.o.init(MTOK, DM, G, bx);
        pg8::EpiMerged2 E{MERGED, PROJ};
        pg8::gemm_phase<pg8::EpiMerged2, pg8::DenseSched8, true, true>(lds, KAB, S, E, tid);
    }
    SEAM(6);
    if (IN(7)) {
        PHASE_ARGS const unsigned char* MERGED = WSP(unsigned char, WS_MERGED); const unsigned char* WO8 = WSP(unsigned char, WS_WO); const float* MOD = WSP(float, WS_MOD); float* X1 = a.out;
        pg8::DenseSched8 S; S.A = (const char*)MERGED; S.Bt = (const char*)WO8; S.K = DM; S.o.init(MTOK, DM, G, bx);
        pg8::EpiX1 E{X1, a.x, MOD};
        pg8::gemm_phase<pg8::EpiX1, pg8::DenseSched8, true, true>(lds, DM, S, E, tid);
    }
    SEAM(7);
    if (IN(8)) {
        PHASE_ARGS const float* MOD = WSP(float, WS_MOD); const float* X1 = a.out; unsigned char* H8 = WSP(unsigned char, WS_H);
        unsigned* TSEL = WSP(unsigned, WS_TSEL); float* TW = WSP(float, WS_TW); unsigned* CNTT = WSP(unsigned, WS_CNTT);
        const bf16_t* WRTH = WSP(bf16_t, WS_WRTH); const bf16_t* WRTL = WSP(bf16_t, WS_WRTL);
        LAS float* rstd_s = (LAS float*)(lds);
        LAS unsigned* lcnt = (LAS unsigned*)(lds + 512);
        LAS float* red = (LAS float*)(lds + 1024);
        LAS float* gsl = (LAS float*)(lds + 69632); LAS float* shl = (LAS float*)(lds + 69632 + 8192);
        for (int rg = bx; rg < MTOK / 32; rg += G) {
            const int m0 = rg * 32; const int b = m0 / SEQ; const float* mod = MOD + b * (6 * DM);
            if (tid < 64) lcnt[tid] = 0u;
            { const int c4 = 4 * tid; const f32x4 g = *(const f32x4*)(a.g_ffn + c4), sh = *(const f32x4*)(mod + 3 * DM + c4), sc = *(const f32x4*)(mod + 4 * DM + c4);
              *(LAS f32x4*)(gsl + c4) = g * (sc + 1.0f); *(LAS f32x4*)(shl + c4) = sh; }
            { const int tok = lane & 31, h8 = lane >> 5;
              const float* xrow = X1 + (size_t)(m0 + tok) * DM + wave * 256 + 8 * h8;
              const size_t wo = (size_t)(b * NE + tok) * DM + wave * 256 + 8 * h8;
              f32x16 d0 = {}, d1 = {};
#pragma unroll 4
              for (int ks = 0; ks < 16; ++ks) { const int kk = 16 * ks;
                  const f32x4 ya = *(const f32x4*)(xrow + kk), yb = *(const f32x4*)(xrow + kk + 4);
                  const bf16x8 ah0 = *(const bf16x8*)(WRTH + wo + kk), al0 = *(const bf16x8*)(WRTL + wo + kk), ah1 = *(const bf16x8*)(WRTH + wo + 32 * DM + kk), al1 = *(const bf16x8*)(WRTL + wo + 32 * DM + kk);
                  u32x4 wh, wl;
                  wh.x = cvt_pk_bf16(ya[0], ya[1]); wh.y = cvt_pk_bf16(ya[2], ya[3]); wh.z = cvt_pk_bf16(yb[0], yb[1]); wh.w = cvt_pk_bf16(yb[2], yb[3]);
                  wl.x = cvt_pk_bf16(ya[0] - bf_lo(wh.x), ya[1] - bf_hi(wh.x)); wl.y = cvt_pk_bf16(ya[2] - bf_lo(wh.y), ya[3] - bf_hi(wh.y));
                  wl.z = cvt_pk_bf16(yb[0] - bf_lo(wh.z), yb[1] - bf_hi(wh.z)); wl.w = cvt_pk_bf16(yb[2] - bf_lo(wh.w), yb[3] - bf_hi(wh.w));
                  const bf16x8 bh = __builtin_bit_cast(bf16x8, wh), bl = __builtin_bit_cast(bf16x8, wl);
                  d0 = __builtin_amdgcn_mfma_f32_32x32x16_bf16(ah0, bh, d0, 0, 0, 0); d0 = __builtin_amdgcn_mfma_f32_32x32x16_bf16(al0, bh, d0, 0, 0, 0); d0 = __builtin_amdgcn_mfma_f32_32x32x16_bf16(ah0, bl, d0, 0, 0, 0);
                  d1 = __builtin_amdgcn_mfma_f32_32x32x16_bf16(ah1, bh, d1, 0, 0, 0); d1 = __builtin_amdgcn_mfma_f32_32x32x16_bf16(al1, bh, d1, 0, 0, 0); d1 = __builtin_amdgcn_mfma_f32_32x32x16_bf16(ah1, bl, d1, 0, 0, 0); }
#pragma unroll
              for (int r = 0; r < 16; ++r) { const int e = (r & 3) + 8 * (r >> 2) + 4 * h8; red[(wave * 32 + tok) * 65 + e] = d0[r]; red[(wave * 32 + tok) * 65 + 32 + e] = d1[r]; } }
            __syncthreads();
            { f32x4 v[4][8];
#pragma unroll
              for (int q = 0; q < 4; ++q) { const f32x4* xr = (const f32x4*)(X1 + (size_t)(m0 + wave * 4 + q) * DM) + lane;
#pragma unroll
                  for (int j = 0; j < 8; ++j) v[q][j] = xr[64 * j]; }
#pragma unroll
              for (int q = 0; q < 4; ++q) { float sq = 0.f;
#pragma unroll
                  for (int j = 0; j < 8; ++j) sq += (v[q][j].x * v[q][j].x + v[q][j].y * v[q][j].y) + (v[q][j].z * v[q][j].z + v[q][j].w * v[q][j].w);
                  const int r = wave * 4 + q;
                  const float rstd = 1.0f / sqrtf(wave_sum(sq) * (1.f / DM) + EPS);
                  if (lane == 0) rstd_s[r] = rstd;
                  unsigned* o4 = (unsigned*)(H8 + (size_t)(m0 + r) * DM) + lane;
#pragma unroll
                  for (int j = 0; j < 8; ++j) { const int col = 4 * lane + 256 * j;
                      const f32x4 y = v[q][j] * rstd * *(const LAS f32x4*)(gsl + col) + *(const LAS f32x4*)(shl + col);
                      unsigned w = 0; w = __builtin_amdgcn_cvt_pk_fp8_f32(y.x, y.y, w, false); w = __builtin_amdgcn_cvt_pk_fp8_f32(y.z, y.w, w, true); o4[64 * j] = w; } } }
            __syncthreads();
            const float ebias = a.e_bias[lane], rbias = WSP(float, WS_RBIAS)[b * NE + lane];
#pragma unroll
            for (int rr = 0; rr < 4; ++rr) { const int r = wave * 4 + rr, m = m0 + r;
                float logit = 0.f;
#pragma unroll
                for (int w = 0; w < 8; ++w) logit += red[(w * 32 + r) * 65 + lane];
                logit = logit * rstd_s[r] + rbias;
                const float s = 1.0f / (1.0f + expf(-logit));
                const float sel = s + ebias;
                const float m1 = grp8_max(sel);
                const int cand = grp8_min((sel == m1) ? lane : 64);
                const float m2 = grp8_max((lane == cand) ? -__builtin_inff() : sel);
                const float gs = m1 + m2; const int mygrp = lane >> 3;
                int grank = 0;
#pragma unroll
                for (int g2 = 0; g2 < 8; ++g2) { const float og = lane_bcast(gs, g2 * 8); grank += (og > gs || (og == gs && g2 < mygrp)) ? 1 : 0; }
                const float v = (grank < 4) ? sel : -__builtin_inff();
                int rank = 0;
#pragma unroll
                for (int j = 0; j < 64; ++j) { const float vj = lane_bcast(v, j); rank += (vj > v || (vj == v && j < lane)) ? 1 : 0; }
                const bool chosen = rank < 8;
                const float tot = wave_sum(chosen ? s : 0.f);
                const unsigned long long bal = __ballot(chosen);
                if (chosen) {
                    const unsigned li = __hip_atomic_fetch_add(lcnt + lane, 1u, __ATOMIC_RELAXED, __HIP_MEMORY_SCOPE_WORKGROUP);
                    const int jj = __builtin_popcountll(bal & ((1ull << lane) - 1ull));
                    TSEL[(size_t)m * 8 + jj] = ((unsigned)lane << 16) | li; TW[(size_t)m * 8 + jj] = s / tot * 2.5f;
                }
            }
            __syncthreads();
            if (tid < 64) CNTT[(size_t)rg * 64 + tid] = lcnt[tid];
            __syncthreads();
        }
    }
    SEAM(8);
    if (IN(9)) {
        PHASE_ARGS const unsigned* CNTT = WSP(unsigned, WS_CNTT); unsigned* TSEL = WSP(unsigned, WS_TSEL); const float* TW = WSP(float, WS_TW);
        unsigned* TOK = WSP(unsigned, WS_TOK); float* GATEW = WSP(float, WS_GATE); unsigned* COUNT = WSP(unsigned, WS_CTL) + CW_COUNT;
        LAS unsigned* part = (LAS unsigned*)lds;
        LAS unsigned* base = (LAS unsigned*)(lds + 8192);
        for (int rg = bx; rg < MTOK / 32; rg += G) {
            { const int e = tid & 63, p8 = tid >> 6; unsigned tot = 0, below = 0;
#pragma unroll 8
              for (int i = 0; i < 32; ++i) { const int rg2 = p8 * 32 + i; const unsigned c = CNTT[(size_t)rg2 * 64 + e]; tot += c; below += (rg2 < rg) ? c : 0u; }
              part[(p8 * 64 + e) * 2] = tot; part[(p8 * 64 + e) * 2 + 1] = below; }
            __syncthreads();
            if (tid < 64) { unsigned t = 0, bl = 0;
#pragma unroll
                for (int p = 0; p < 8; ++p) { t += part[(p * 64 + tid) * 2]; bl += part[(p * 64 + tid) * 2 + 1]; }
                base[tid] = bl; if (rg == 0) COUNT[tid] = t; }
            __syncthreads();
            if (tid < 256) { const int m = rg * 32 + (tid >> 3), jj = tid & 7; const unsigned ts = TSEL[(size_t)m * 8 + jj]; const unsigned e2 = ts >> 16, slot = base[e2] + (ts & 0xffffu);
                TOK[(size_t)e2 * ECAP + slot] = (unsigned)m; GATEW[(size_t)e2 * ECAP + slot] = TW[(size_t)m * 8 + jj]; TSEL[(size_t)m * 8 + jj] = (e2 << 16) | slot; }
            __syncthreads();
        }
        bg_fill(a, ws, MISC, -1, G, wave, tid, lane);
    }
    SEAM(9);
    if (IN(10) || IN(11) || IN(12)) {
        PHASE_ARGS const unsigned* COUNT = WSP(unsigned, WS_CTL) + CW_COUNT;
        if (tid < NEX) MISC[MI_CNT + tid] = (tid < NE) ? COUNT[tid] : (unsigned)MTOK;
        __syncthreads();
        if (tid == 0) { unsigned acc = 0; for (int e = 0; e < NEX; ++e) { MISC[MI_TP + e] = acc; acc += (MISC[MI_CNT + e] + 255u) >> 8; } MISC[MI_TP + NEX] = acc; }
        __syncthreads();
    }
    LAS const int* tp = (LAS const int*)(lds + MISC_OFF + 4 * MI_TP); LAS const int* cnt = (LAS const int*)(lds + MISC_OFF + 4 * MI_CNT);
    if (IN(10)) {
        PHASE_ARGS const unsigned char* H = WSP(unsigned char, WS_H); const unsigned char* W13 = WSP(unsigned char, WS_W13); const unsigned* TOK = WSP(unsigned, WS_TOK); const float* GATEW = WSP(float, WS_GATE); unsigned char* HID = WSP(unsigned char, WS_HID);
        MoeSched1 S{(const char*)H, (const char*)W13, TOK, tp, cnt, G, bx, lane};
        pg8::EpiHid E{HID, GATEW, cnt};
        pg8::gemm_phase<pg8::EpiHid, MoeSched1, true, true>(lds, DM, S, E, tid);
    }
    SEAM(10);
    if (IN(11)) {
        PHASE_ARGS const unsigned char* HID = WSP(unsigned char, WS_HID); const unsigned char* W2 = WSP(unsigned char, WS_W2); unsigned char* Y = WSP(unsigned char, WS_Y);
        MoeSched2 S{(const char*)HID, (const char*)W2, tp, G, bx, lane};
        pg8::EpiY E{Y};
        pg8::gemm_phase<pg8::EpiY, MoeSched2, true, true>(lds, DE, S, E, tid);
    }
    SEAM(11);
    if (IN(12)) {
        PHASE_ARGS const float* MOD = WSP(float, WS_MOD); const unsigned char* Y = WSP(unsigned char, WS_Y); const unsigned* TSEL = WSP(unsigned, WS_TSEL);
#pragma unroll 1
        for (int m = gw; m < MTOK; m += NGW) {
            unsigned lo8 = 16u * (unsigned)lane, lo32 = 64u * (unsigned)lane;
            asm volatile("" : "+v"(lo8), "+v"(lo32));
            const int b = m / SEQ; const char* gt2 = (const char*)(MOD + b * (6 * DM) + 5 * DM); const char* gfin = (const char*)a.g_final;
            char* xrow = (char*)(a.out + (size_t)m * DM);
            const u32x4 tsa = *(const u32x4*)(TSEL + (size_t)m * 8), tsb = *(const u32x4*)(TSEL + (size_t)m * 8 + 4);
            const unsigned char* yrow[9];
            { const unsigned tsv[8] = {tsa.x, tsa.y, tsa.z, tsa.w, tsb.x, tsb.y, tsb.z, tsb.w};
#pragma unroll
              for (int k = 0; k < 8; ++k) { const unsigned ts = (unsigned)__builtin_amdgcn_readfirstlane((int)tsv[k]); yrow[k] = Y + ((size_t)tp[ts >> 16] * 256 + (ts & 0xffffu)) * DM; } }
            yrow[8] = Y + ((size_t)tp[NE] * 256 + m) * DM;
            f32x4 sv[2][4];
#pragma unroll
            for (int j = 0; j < 2; ++j)
#pragma unroll
                for (int q = 0; q < 4; ++q) sv[j][q] = (f32x4){0.f, 0.f, 0.f, 0.f};
#define P12_BATCH(K0, KN) do { u32x4 yv[KN][2]; \
            _Pragma("unroll") for (int k = 0; k < KN; ++k) _Pragma("unroll") for (int j = 0; j < 2; ++j) yv[k][j] = *(const u32x4*)(yrow[K0 + k] + lo8 + 1024u * j); \
            _Pragma("unroll") for (int k = 0; k < KN; ++k) _Pragma("unroll") for (int j = 0; j < 2; ++j) _Pragma("unroll") for (int q = 0; q < 4; ++q) { \
                const unsigned w = yv[k][j][q]; const f32x2 lo = __builtin_amdgcn_cvt_pk_f32_fp8(w, false), hi = __builtin_amdgcn_cvt_pk_f32_fp8(w, true); \
                sv[j][q][0] += lo.x; sv[j][q][1] += lo.y; sv[j][q][2] += hi.x; sv[j][q][3] += hi.y; } } while (0)
            P12_BATCH(6, 3); __builtin_amdgcn_sched_barrier(0);
            P12_BATCH(3, 3); __builtin_amdgcn_sched_barrier(0);
            P12_BATCH(0, 3); __builtin_amdgcn_sched_barrier(0);
#undef P12_BATCH
            float ss = 0.f;
#pragma unroll
            for (int j = 0; j < 2; ++j)
#pragma unroll
                for (int q = 0; q < 4; ++q) { const unsigned off = lo32 + 4096u * j + 16u * q; const f32x4 g = *(const f32x4*)(gt2 + off);
                    const f32x4 x2 = *(const f32x4*)(xrow + off) + g * (sv[j][q] * (1.0f / Y8_SCALE)); sv[j][q] = x2;
                    ss += (x2.x * x2.x + x2.y * x2.y) + (x2.z * x2.z + x2.w * x2.w); }
            const float rstd = 1.0f / sqrtf(wave_sum(ss) * (1.f / DM) + EPS);
#pragma unroll
            for (int j = 0; j < 2; ++j)
#pragma unroll
                for (int q = 0; q < 4; ++q) { const unsigned off = lo32 + 4096u * j + 16u * q; *(f32x4*)(xrow + off) = sv[j][q] * rstd * *(const f32x4*)(gfin + off); }
        }
    }
#undef IN
#undef SEAM
}

extern "C" void kernel_launch(void* const* d_in, const int* in_sizes, int n_in, void* d_out, int out_size, void* d_ws, size_t ws_size, hipStream_t stream) {
    static int grid = 0;
    if (grid == 0) {
        if (n_in != 22 || out_size != MTOK * DM || ws_size < WS_END) { fprintf(stderr, "kernel_launch: unexpected shapes (n_in %d out %d ws %zu)\n", n_in, out_size, ws_size); grid = -1; return; }
        int dev = 0, cus = 0;
        if (hipGetDevice(&dev) != hipSuccess || hipDeviceGetAttribute(&cus, hipDeviceAttributeMultiprocessorCount, dev) != hipSuccess) { grid = -1; return; }
        if (hipFuncSetAttribute((const void*)fwd_kernel, hipFuncAttributeMaxDynamicSharedMemorySize, LDS_BYTES) != hipSuccess) { fprintf(stderr, "kernel_launch: hipFuncSetAttribute failed\n"); grid = -1; return; }
        int per_cu = 0;
        if (hipOccupancyMaxActiveBlocksPerMultiprocessor(&per_cu, (const void*)fwd_kernel, NTHREADS, LDS_BYTES) != hipSuccess || per_cu < 1) { fprintf(stderr, "kernel_launch: occupancy query says %d\n", per_cu); }
        (void)hipGetLastError();
        grid = cus;
    }
    if (grid < 0) return;
    (void)hipMemsetAsync((char*)d_ws + WS_CTL, 0, CTL_ZERO_BYTES, stream);
    Args a{};
    const float** pp = (const float**)&a.x;
    for (int i = 0; i < 22; ++i) pp[i] = (const float*)d_in[i];
    a.out = (float*)d_out; a.ws = (unsigned char*)d_ws;
    if (MK_N_LAUNCHES == 1) {
        a.ph_lo = 0; a.ph_hi = NPHASE;
        hipLaunchKernelGGL(fwd_kernel, dim3(grid), dim3(NTHREADS), LDS_BYTES, stream, a);
    } else {
        for (int p = 0; p < NPHASE; ++p) for (int rep = 0; rep < 1 + ((PROBE_REP >> p) & 1); ++rep) {
            a.ph_lo = p; a.ph_hi = p + 1; hipLaunchKernelGGL(fwd_kernel, dim3(grid), dim3(NTHREADS), LDS_BYTES, stream, a); }
    }
}
```
